# Optimizing an MI355X kernel written in HIP

```python
import jax
import jax.numpy as jnp
from jax import lax
import numpy as np

D_MODEL = 2048
BATCH = 4
SEQ = 8192
DEPTH = 1
DEC_BATCH = 1
DEC_SEQ = 16384
PAST_LEN = 128

GRID_W = 64
HEAD_DIM = 64
ATT_WIDTH = D_MODEL // 2
RWKV_WIDTH = D_MODEL - ATT_WIDTH
N_ATT_HEADS = ATT_WIDTH // HEAD_DIM
N_RWKV_HEADS = RWKV_WIDTH // HEAD_DIM
WIN_ROWS_MAX = 8
WIN_COLS = 16
DECAY_LORA = 64
ICLR_LORA = 64
GATE_LORA = 160
N_DIR = 2
ATT_COLS = 3 * ATT_WIDTH
RWKV_COLS = 3 * RWKV_WIDTH + N_DIR * DECAY_LORA + N_DIR * ICLR_LORA + GATE_LORA
PROJ_COLS = ATT_COLS + RWKV_COLS
D_FF = ((8 * D_MODEL + 3 * 256 - 1) // (3 * 256)) * 256
RMS_EPS = 1e-6
LNX_EPS = 64e-5

kernel_name = 'hymba_natten_rwkv7_bidir_encoder'


def rmsnorm(x, g):
    xf = x.astype(jnp.float32)
    y = xf * lax.rsqrt(jnp.mean(xf * xf, axis=-1, keepdims=True) + RMS_EPS)
    return (y * g.astype(jnp.float32)).astype(x.dtype)


def neighbourhood_attention(q, k, v, rpb):
    b, t, h, d = q.shape
    rows = t // GRID_W
    kr = min(WIN_ROWS_MAX, rows)
    qg = q.reshape(b, rows, GRID_W, h, d)
    kg = k.reshape(b, rows, GRID_W, h, d)
    vg = v.reshape(b, rows, GRID_W, h, d)
    col = jnp.arange(GRID_W)
    col_start = jnp.clip(col - WIN_COLS // 2, 0, GRID_W - WIN_COLS)
    col_idx = col_start[:, None] + jnp.arange(WIN_COLS)[None, :]
    dcol = col_idx - col[:, None] + (WIN_COLS - 1)
    rpb = rpb.astype(jnp.float32)
    scale = d ** -0.5

    def row_block(r):
        r0 = jnp.clip(r - kr // 2, 0, rows - kr)
        q_r = lax.dynamic_index_in_dim(qg, r, axis=1, keepdims=False)
        k_r = lax.dynamic_slice_in_dim(kg, r0, kr, axis=1)
        v_r = lax.dynamic_slice_in_dim(vg, r0, kr, axis=1)
        k_n = k_r[:, :, col_idx]
        v_n = v_r[:, :, col_idx]
        drow = r0 + jnp.arange(kr) - r + (WIN_ROWS_MAX - 1)
        bias = rpb[:, drow[None, :, None], dcol[:, None, :]]
        s = jnp.einsum('bqhd,bkqjhd->bhqkj', q_r, k_n, preferred_element_type=jnp.float32)
        s = s * scale + bias
        p = jax.nn.softmax(s.reshape(b, h, GRID_W, kr * WIN_COLS), axis=-1)
        p = p.reshape(b, h, GRID_W, kr, WIN_COLS).astype(v.dtype)
        return jnp.einsum('bhqkj,bkqjhd->bqhd', p, v_n)

    out = lax.map(row_block, jnp.arange(rows))
    return jnp.transpose(out, (1, 0, 2, 3, 4)).reshape(b, t, h, d)


def rwkv7_time_mix(u, mu_prev, mu_next, w0, w2, a0, a2, g2, k_k, k_a, r_k, lnx_w, lnx_b):
    b, t, _ = u.shape
    c, h, n = RWKV_WIDTH, N_RWKV_HEADS, HEAD_DIM
    out_dtype = u.dtype
    u_prev = jnp.pad(u[:, :-1], ((0, 0), (1, 0), (0, 0)))
    u_next = jnp.pad(u[:, 1:], ((0, 0), (0, 1), (0, 0)))
    u = u + mu_prev * (u_prev - u) + mu_next * (u_next - u)
    splits = [c, 2 * c, 3 * c, 3 * c + N_DIR * DECAY_LORA, 3 * c + N_DIR * DECAY_LORA + N_DIR * ICLR_LORA]
    r, k, v, wd, ad, gd = jnp.split(u.astype(jnp.float32), splits, axis=-1)
    wd = wd.reshape(b, t, N_DIR, DECAY_LORA)
    ad = ad.reshape(b, t, N_DIR, ICLR_LORA)
    w_log = -jax.nn.softplus(-(w0 + jnp.einsum('btel,elc->btec', jnp.tanh(wd), w2))) - 0.5
    decay = jnp.exp(-jnp.exp(w_log))
    a = jax.nn.sigmoid(a0 + jnp.einsum('btel,elc->btec', ad, a2))
    g = jnp.einsum('btl,lc->btc', jax.nn.sigmoid(gd), g2)
    kk = (k * k_k).reshape(b, t, h, n)
    kk = (kk / jnp.maximum(jnp.sqrt(jnp.sum(kk * kk, axis=-1, keepdims=True)), 1e-12)).reshape(b, t, c)
    k_dir = k[:, :, None, :] * (1.0 + (a - 1.0) * k_a)

    def dirs(z):
        z = z.reshape(b, t, N_DIR, h, n)
        z = jnp.stack([z[:, :, 0], jnp.flip(z[:, :, 1], axis=1)], axis=0)
        return jnp.transpose(z, (2, 0, 1, 3, 4))

    def both(z):
        return jnp.broadcast_to(z[:, :, None, :], (b, t, N_DIR, c))

    xs = (dirs(both(r)), dirs(decay), dirs(k_dir), dirs(both(v)),
          dirs(both(-kk)), dirs(kk[:, :, None, :] * a))

    def step(S, inp):
        r_t, w_t, k_t, v_t, z_t, bb_t = inp
        sz = jnp.einsum('ebhvk,ebhk->ebhv', S, z_t)
        S = S * w_t[..., None, :] + sz[..., None] * bb_t[..., None, :] + v_t[..., None] * k_t[..., None, :]
        return S, jnp.einsum('ebhvk,ebhk->ebhv', S, r_t)

    S0 = jnp.zeros((N_DIR, b, h, n, n), jnp.float32)
    _, ys = lax.scan(step, S0, xs)
    y = ys[:, 0] + jnp.flip(ys[:, 1], axis=0)
    y = jnp.transpose(y, (1, 0, 2, 3))
    mu = jnp.mean(y, axis=-1, keepdims=True)
    var = jnp.mean(jnp.square(y - mu), axis=-1, keepdims=True)
    yn = ((y - mu) * lax.rsqrt(var + LNX_EPS)).reshape(b, t, c) * lnx_w + lnx_b
    bonus = jnp.sum((r * (k_dir[:, :, 0] + k_dir[:, :, 1])).reshape(b, t, h, n) * r_k,
                    axis=-1, keepdims=True) * v.reshape(b, t, h, n)
    out = (yn + bonus.reshape(b, t, c)) * g
    return out.astype(out_dtype)


def encoder_trunk(x, norm1_g, w_in, attn_rpb, attn_out_g, mu_prev, mu_next, w0, w2, a0, a2, g2,
                  k_k, k_a, r_k, lnx_w, lnx_b, w_out, norm2_g, w_gate, w_up, w_down, final_g):
    b, t, _ = x.shape
    for l in range(DEPTH):
        hn = rmsnorm(x, norm1_g[l])
        proj = jnp.einsum('btd,dp->btp', hn, w_in[l])
        q, k, v = jnp.split(proj[..., :ATT_COLS], 3, axis=-1)
        q = q.reshape(b, t, N_ATT_HEADS, HEAD_DIM)
        k = k.reshape(b, t, N_ATT_HEADS, HEAD_DIM)
        v = v.reshape(b, t, N_ATT_HEADS, HEAD_DIM)
        att = neighbourhood_attention(q, k, v, attn_rpb[l]).reshape(b, t, ATT_WIDTH)
        att = rmsnorm(att, attn_out_g[l])
        rw = rwkv7_time_mix(proj[..., ATT_COLS:], mu_prev[l], mu_next[l], w0[l], w2[l], a0[l], a2[l],
                            g2[l], k_k[l], k_a[l], r_k[l], lnx_w[l], lnx_b[l])
        x = x + jnp.einsum('btc,cd->btd', jnp.concatenate([att, rw], axis=-1), w_out[l])
        hn = rmsnorm(x, norm2_g[l])
        ff = jax.nn.silu(hn @ w_gate[l]) * (hn @ w_up[l])
        x = x + ff @ w_down[l]
    return rmsnorm(x, final_g)


def setup_inputs(seed: int = 0) -> dict:
    key = jax.random.key(seed)
    ks = jax.random.split(key, 26)
    f = jnp.float32
    L, C, H = DEPTH, RWKV_WIDTH, N_RWKV_HEADS

    def nrm(k, shape, s):
        return jax.random.normal(k, shape, f) * s

    return {
        'x_prompt': nrm(ks[0], (BATCH, SEQ, D_MODEL), 1.0),
        'x_sample': nrm(ks[1], (DEC_BATCH, DEC_SEQ, D_MODEL), 1.0),
        'norm1_g': 1.0 + nrm(ks[2], (L, D_MODEL), 0.05),
        'w_in': nrm(ks[3], (L, D_MODEL, PROJ_COLS), D_MODEL ** -0.5),
        'attn_rpb': nrm(ks[4], (L, N_ATT_HEADS, 2 * WIN_ROWS_MAX - 1, 2 * WIN_COLS - 1), 0.1),
        'attn_out_g': 1.0 + nrm(ks[5], (L, ATT_WIDTH), 0.05),
        'mu_prev': jax.random.uniform(ks[6], (L, RWKV_COLS), f, 0.0, 0.5),
        'mu_next': jax.random.uniform(ks[7], (L, RWKV_COLS), f, 0.0, 0.5),
        'w0': jax.random.uniform(ks[8], (L, N_DIR, C), f, -6.0, 1.0),
        'w2': nrm(ks[9], (L, N_DIR, DECAY_LORA, C), 0.1),
        'a0': nrm(ks[10], (L, N_DIR, C), 0.1),
        'a2': nrm(ks[11], (L, N_DIR, ICLR_LORA, C), 0.1),
        'g2': nrm(ks[12], (L, GATE_LORA, C), GATE_LORA ** -0.5),
        'k_k': 0.85 + nrm(ks[13], (L, C), 0.05),
        'k_a': 1.0 + nrm(ks[14], (L, C), 0.05),
        'r_k': nrm(ks[15], (L, H, HEAD_DIM), 0.1),
        'lnx_w': 1.0 + nrm(ks[16], (L, C), 0.05),
        'lnx_b': nrm(ks[17], (L, C), 0.02),
        'w_out': nrm(ks[18], (L, D_MODEL, D_MODEL), D_MODEL ** -0.5),
        'norm2_g': 1.0 + nrm(ks[19], (L, D_MODEL), 0.05),
        'w_gate': nrm(ks[20], (L, D_MODEL, D_FF), D_MODEL ** -0.5),
        'w_up': nrm(ks[21], (L, D_MODEL, D_FF), D_MODEL ** -0.5),
        'w_down': nrm(ks[22], (L, D_FF, D_MODEL), D_FF ** -0.5),
        'final_g': 1.0 + nrm(ks[23], (D_MODEL,), 0.05),
    }


def reference(x_prompt, x_sample, norm1_g, w_in, attn_rpb, attn_out_g, mu_prev, mu_next, w0, w2, a0, a2,
              g2, k_k, k_a, r_k, lnx_w, lnx_b, w_out, norm2_g, w_gate, w_up, w_down, final_g):
    y_prompt = encoder_trunk(x_prompt, norm1_g, w_in, attn_rpb, attn_out_g, mu_prev, mu_next, w0, w2, a0, a2,
                             g2, k_k, k_a, r_k, lnx_w, lnx_b, w_out, norm2_g, w_gate, w_up, w_down, final_g)
    y_sample = encoder_trunk(x_sample, norm1_g, w_in, attn_rpb, attn_out_g, mu_prev, mu_next, w0, w2, a0, a2,
                             g2, k_k, k_a, r_k, lnx_w, lnx_b, w_out, norm2_g, w_gate, w_up, w_down, final_g)
    return (y_prompt, y_sample)
```

```cpp
#include <hip/hip_runtime.h>
#include <hip/hip_cooperative_groups.h>
#include <cstdio>
#include <cstdint>
namespace cg = cooperative_groups;
namespace pg8 {
#define PG8_LAS __attribute__((address_space(3)))
typedef unsigned short bf16_t;
typedef short bf16x8 __attribute__((ext_vector_type(8)));
typedef float f32x4 __attribute__((ext_vector_type(4)));
typedef unsigned u32x4 __attribute__((ext_vector_type(4)));
constexpr int BM = 256, BK = 64, HALF = 128, HTB = HALF * BK * 2  , STAGE_BYTES = 8 * HTB, NXCD = 8, WGM = 8;

__host__ __device__ __forceinline__ int lds_byte(int r, int c) { const int st = (r >> 4) * 2 + (c >> 5), rr = r & 15, cc = c & 31, ob = rr * 64 + cc * 2; return st * 1024 + (ob ^ (((ob >> 9) & 1) << 5)); }
__host__ __device__ __forceinline__ void stage_rc(int b, int& R, int& C) { const int st = b / 1024, sb = b % 1024, swz = sb ^ (((sb >> 9) & 1) << 5); R = (st >> 1) * 16 + swz / 64; C = (st & 1) * 32 + (swz % 64) / 2; }
__host__ __device__ __forceinline__ int perm32(int rho) { const int n = rho >> 4, i = rho & 15; return 8 * (i >> 2) + 4 * n + (i & 3); }

struct Unit { int pm, pn; };
struct Gemm { const bf16_t* A; const bf16_t* Bt; int M, N, K, lda, ldb; };

struct StaticOrder {
    int nM, nN, nwg, G, c;
    __host__ __device__ void init(int M, int N, int G_, int c_) { nM = M / BM; nN = N / BM; nwg = nM * nN; G = G_; c = c_; }
    __host__ __device__ bool next(int i, Unit& u) const {
        const long L = (long)i * G + c; if (L >= nwg) return false;
        int wgid = (int)L; { const int q = nwg / NXCD, r = nwg % NXCD, xcd = wgid % NXCD, off = wgid / NXCD; wgid = (xcd < r ? xcd * (q + 1) : r * (q + 1) + (xcd - r) * q) + off; }
        const int nig = WGM * nN, gid = wgid / nig, fm = gid * WGM, gsz = (nM - fm) < WGM ? (nM - fm) : WGM;
        u.pm = fm + ((wgid % nig) % gsz); u.pn = (wgid % nig) / gsz; return true;
    }
    __device__ __forceinline__ void a_ready(const Unit&) const {}
    __device__ __forceinline__ void done(const Unit&) const {}
};
__device__ __forceinline__ unsigned cvt_pk_bf16(float lo, float hi) { unsigned r; asm volatile("v_cvt_pk_bf16_f32 %0, %1, %2" : "=v"(r) : "v"(lo), "v"(hi)); return r; }
__device__ __forceinline__ u32x4 pack8(const f32x4 v0, const f32x4 v1) { u32x4 w; w.x = cvt_pk_bf16(v0[0], v0[1]); w.y = cvt_pk_bf16(v0[2], v0[3]); w.z = cvt_pk_bf16(v1[0], v1[1]); w.w = cvt_pk_bf16(v1[2], v1[3]); return w; }
__device__ __forceinline__ float sigmoidf_(float x) { return 1.0f / (1.0f + __expf(-x)); }

struct EpiProj {
    static constexpr bool PERM = true, AFTER_DRAIN = false;
    bf16_t* att; bf16_t* rw; const float* rstd;
    __device__ __forceinline__ void operator()(const f32x4 (&acc)[2][2][4][2], const Unit& u, int wr, int wc, int fr, int fq) const {
        const int colt = u.pn * BM; bf16_t* base; int ld, c0;
        if (colt < 3072) { base = att; ld = 3072; c0 = colt; } else { base = rw; ld = 3584; c0 = colt - 3072; }
        c0 += wc * 32 + 8 * fq;
#pragma unroll
        for (int ai = 0; ai < 2; ++ai)
#pragma unroll
            for (int m = 0; m < 4; ++m) { const int row = u.pm * BM + ai * HALF + wr * 64 + m * 16 + fr; const float s = rstd[row]; bf16_t* rowp = base + (size_t)row * ld + c0;
#pragma unroll
                for (int bj = 0; bj < 2; ++bj) *(u32x4*)(rowp + bj * HALF) = pack8(acc[ai][bj][m][0] * s, acc[ai][bj][m][1] * s); }
    }
};
template <int MODE> struct EpiLora {
    static constexpr bool PERM = true, AFTER_DRAIN = false;
    bf16_t* O; int ldc; const float* bias;
    __device__ __forceinline__ float f(float v) const {
        if (MODE == 0) return 1.0f - __expf(-0.60653066f * sigmoidf_(v));
        if (MODE == 1) return sigmoidf_(v);
        return v;
    }
    __device__ __forceinline__ void operator()(const f32x4 (&acc)[2][2][4][2], const Unit& u, int wr, int wc, int fr, int fq) const {
        const int col0 = u.pn * BM + wc * 32 + 8 * fq;
#pragma unroll
        for (int bj = 0; bj < 2; ++bj) {
            const f32x4 b0 = (MODE != 2) ? *(const f32x4*)(bias + col0 + bj * HALF) : (f32x4){0.f, 0.f, 0.f, 0.f}, b1 = (MODE != 2) ? *(const f32x4*)(bias + col0 + bj * HALF + 4) : (f32x4){0.f, 0.f, 0.f, 0.f};
#pragma unroll
            for (int ai = 0; ai < 2; ++ai)
#pragma unroll
                for (int m = 0; m < 4; ++m) { const int row = u.pm * BM + ai * HALF + wr * 64 + m * 16 + fr; bf16_t* rowp = O + (size_t)row * ldc + col0;
                    f32x4 v0 = acc[ai][bj][m][0] + b0, v1 = acc[ai][bj][m][1] + b1;
#pragma unroll
                    for (int j = 0; j < 4; ++j) { v0[j] = f(v0[j]); v1[j] = f(v1[j]); }
                    *(u32x4*)(rowp + bj * HALF) = pack8(v0, v1); }
        }
    }
};
struct EpiOut {
    static constexpr bool PERM = true, AFTER_DRAIN = false;
    const float* xp; const float* xs; bf16_t* xb; float* ss;
    __device__ __forceinline__ void operator()(const f32x4 (&acc)[2][2][4][2], const Unit& u, int wr, int wc, int fr, int fq) const {
        const int col0 = u.pn * BM + wc * 32 + 8 * fq;
#pragma unroll
        for (int ai = 0; ai < 2; ++ai)
#pragma unroll
            for (int m = 0; m < 4; ++m) { const int row = u.pm * BM + ai * HALF + wr * 64 + m * 16 + fr;
                const float* xin = (row < 32768 ? xp + (size_t)row * 2048 : xs + (size_t)(row - 32768) * 2048) + col0;
                bf16_t* bp = xb + (size_t)row * 2048 + col0; float sq = 0.f;
#pragma unroll
                for (int bj = 0; bj < 2; ++bj) { const f32x4 x0 = *(const f32x4*)(xin + bj * HALF) + acc[ai][bj][m][0], x1 = *(const f32x4*)(xin + bj * HALF + 4) + acc[ai][bj][m][1];
                    *(u32x4*)(bp + bj * HALF) = pack8(x0, x1);
                    sq += (x0[0] * x0[0] + x0[1] * x0[1]) + (x0[2] * x0[2] + x0[3] * x0[3]) + (x1[0] * x1[0] + x1[1] * x1[1]) + (x1[2] * x1[2] + x1[3] * x1[3]); }
                sq += __shfl_xor(sq, 16); sq += __shfl_xor(sq, 32);
                if (fq == 0) atomicAdd(ss + row, sq); }
    }
};
struct EpiGU {
    static constexpr bool PERM = true, AFTER_DRAIN = false;
    bf16_t* H; const float* ss;
    __device__ __forceinline__ void operator()(const f32x4 (&acc)[2][2][4][2], const Unit& u, int wr, int wc, int fr, int fq) const {
        const int col0 = u.pn * HALF + wc * 32 + 8 * fq;
#pragma unroll
        for (int ai = 0; ai < 2; ++ai)
#pragma unroll
            for (int m = 0; m < 4; ++m) { const int row = u.pm * BM + ai * HALF + wr * 64 + m * 16 + fr; const float rs = rsqrtf(ss[row] * (1.0f / 2048.0f) + 1e-6f);
                f32x4 h[2];
#pragma unroll
                for (int n = 0; n < 2; ++n)
#pragma unroll
                    for (int j = 0; j < 4; ++j) { const float g = acc[ai][0][m][n][j] * rs, uu = acc[ai][1][m][n][j] * rs; h[n][j] = g * uu * sigmoidf_(g); }
                *(u32x4*)(H + (size_t)row * 5632 + col0) = pack8(h[0], h[1]); }
    }
};
struct EpiDown {
    static constexpr bool PERM = true, AFTER_DRAIN = false;
    bf16_t* xb; float* ss;
    __device__ __forceinline__ void operator()(const f32x4 (&acc)[2][2][4][2], const Unit& u, int wr, int wc, int fr, int fq) const {
        const int col0 = u.pn * BM + wc * 32 + 8 * fq;
#pragma unroll
        for (int ai = 0; ai < 2; ++ai)
#pragma unroll
            for (int m = 0; m < 4; ++m) { const int row = u.pm * BM + ai * HALF + wr * 64 + m * 16 + fr; bf16_t* bp = xb + (size_t)row * 2048 + col0; float sq = 0.f;
#pragma unroll
                for (int bj = 0; bj < 2; ++bj) { const u32x4 w = *(const u32x4*)(bp + bj * HALF);
                    const f32x4 x0 = (f32x4){__uint_as_float(w.x << 16), __uint_as_float(w.x & 0xffff0000u), __uint_as_float(w.y << 16), __uint_as_float(w.y & 0xffff0000u)} + acc[ai][bj][m][0];
                    const f32x4 x1 = (f32x4){__uint_as_float(w.z << 16), __uint_as_float(w.z & 0xffff0000u), __uint_as_float(w.w << 16), __uint_as_float(w.w & 0xffff0000u)} + acc[ai][bj][m][1];
                    *(u32x4*)(bp + bj * HALF) = pack8(x0, x1);
                    sq += (x0[0] * x0[0] + x0[1] * x0[1]) + (x0[2] * x0[2] + x0[3] * x0[3]) + (x1[0] * x1[0] + x1[1] * x1[1]) + (x1[2] * x1[2] + x1[3] * x1[3]); }
                sq += __shfl_xor(sq, 16); sq += __shfl_xor(sq, 32);
                if (fq == 0) atomicAdd(ss + row, sq); }
    }
};
template <class Epi, class Sched, bool ALIGN_EPI = false, bool SP2 = false>
__device__ __forceinline__ void gemm_phase(PG8_LAS unsigned char* lds, const Gemm g, const Sched& S, const Epi& E) {
    int tid_ = threadIdx.x; asm volatile("" : "+v"(tid_));
    const int tid = tid_, wid = __builtin_amdgcn_readfirstlane(tid >> 6), lane = tid & 63, wr = wid >> 2, wc = wid & 3, fr = lane & 15, fq = lane >> 4;
    const int K = g.K, nt = K / BK;
    unsigned voffA[2], voffB[2];
#pragma unroll
    for (int i = 0; i < 2; ++i) { int R, C; stage_rc(tid * 16 + i * 8192, R, C); const int Rb = Epi::PERM ? ((R & ~31) + perm32(R & 31)) : R;
        voffA[i] = (unsigned)(R * g.lda + C) * 2u; voffB[i] = (unsigned)(Rb * g.ldb + C) * 2u; }
    const size_t kstep = (size_t)(BK * 2);
    const size_t hstepA = (size_t)HALF * g.lda * 2, hstepB = (size_t)HALF * g.ldb * 2;
    const size_t tstepA = 2 * hstepA, tstepB = 2 * hstepB;
    const unsigned ldsw = (unsigned)wid * 1024u;
    const int aoff = lds_byte(wr * 64 + fr, fq * 8), boff = lds_byte(wc * 32 + fr, fq * 8);
#define PG8_SA(b, h) (((b) * 2 + (h)) * HTB)
#define PG8_SB(b, h) ((4 + (b) * 2 + (h)) * HTB)
#define PG8_STAGE(bufoff, gbase, voff) do { _Pragma("unroll") for (int _i = 0; _i < 2; ++_i) \
        __builtin_amdgcn_global_load_lds((const unsigned*)((const char*)(gbase) + (voff)[_i]), (PG8_LAS unsigned*)(lds + (bufoff) + ldsw + _i * 8192), 16, 0, 0); } while (0)
#define PG8_LDA(dst, b, h) do { _Pragma("unroll") for (int m = 0; m < 4; ++m) _Pragma("unroll") for (int k = 0; k < 2; ++k) dst[m][k] = *(const PG8_LAS bf16x8*)(lds + PG8_SA(b, h) + aoff + m * 2048 + k * 1024); } while (0)
#define PG8_LDB(dst, b, h) do { _Pragma("unroll") for (int n = 0; n < 2; ++n) _Pragma("unroll") for (int k = 0; k < 2; ++k) dst[n][k] = *(const PG8_LAS bf16x8*)(lds + PG8_SB(b, h) + boff + n * 2048 + k * 1024); } while (0)
#define PG8_MMA(ai, bj, At, Bt) do { __builtin_amdgcn_s_setprio(1); _Pragma("unroll") for (int m = 0; m < 4; ++m) _Pragma("unroll") for (int n = 0; n < 2; ++n) _Pragma("unroll") for (int k = 0; k < 2; ++k) \
        acc[ai][bj][m][n] = __builtin_amdgcn_mfma_f32_16x16x32_bf16(Bt[n][k], At[m][k], acc[ai][bj][m][n], 0, 0, 0); __builtin_amdgcn_s_setprio(0); } while (0)
#define PG8_WAIT_V(n) asm volatile("s_waitcnt vmcnt(" #n ")" ::: "memory")
#define PG8_WAIT_L(n) asm volatile("s_waitcnt lgkmcnt(" #n ")" ::: "memory")
#define PG8_BAR __builtin_amdgcn_s_barrier()
#define PG8_SCHED __builtin_amdgcn_sched_barrier(0)
    Unit cur, nxt; int ui = 0;
    if (!S.next(0, cur)) return;
    f32x4 acc[2][2][4][2];
#pragma unroll
    for (int a = 0; a < 2; ++a)
#pragma unroll
        for (int b = 0; b < 2; ++b)
#pragma unroll
            for (int m = 0; m < 4; ++m)
#pragma unroll
                for (int n = 0; n < 2; ++n) acc[a][b][m][n] = (f32x4){0.f, 0.f, 0.f, 0.f};
    bf16x8 At[4][2], B0[2][2], B1[2][2];
    const char* cA = (const char*)g.A + (size_t)cur.pm * tstepA; const char* cB = (const char*)g.Bt + (size_t)cur.pn * tstepB;
    S.a_ready(cur);
    if constexpr (SP2) {
        PG8_STAGE(PG8_SB(0, 0), cB, voffB); PG8_STAGE(PG8_SB(0, 1), cB + hstepB, voffB); PG8_STAGE(PG8_SA(0, 0), cA, voffA); PG8_STAGE(PG8_SA(0, 1), cA + hstepA, voffA);
        if (wr == 1) PG8_BAR;
        PG8_WAIT_V(2); PG8_BAR;
        PG8_STAGE(PG8_SB(1, 0), cB + kstep, voffB); PG8_STAGE(PG8_SA(1, 0), cA + kstep, voffA); PG8_STAGE(PG8_SB(1, 1), cB + hstepB + kstep, voffB);
        PG8_WAIT_V(6); PG8_BAR;
    } else {
        PG8_STAGE(PG8_SB(0, 0), cB, voffB); PG8_STAGE(PG8_SA(0, 0), cA, voffA); PG8_STAGE(PG8_SB(0, 1), cB + hstepB, voffB); PG8_STAGE(PG8_SA(0, 1), cA + hstepA, voffA);
        if (wr == 1) PG8_BAR;
        PG8_WAIT_V(4); PG8_BAR;
        PG8_STAGE(PG8_SB(1, 0), cB + kstep, voffB); PG8_STAGE(PG8_SA(1, 0), cA + kstep, voffA); PG8_STAGE(PG8_SB(1, 1), cB + hstepB + kstep, voffB);
        PG8_WAIT_V(6); PG8_BAR;
    }
    for (;;) {
        const bool has_next = S.next(ui + 1, nxt);
        const char* nA = has_next ? (const char*)g.A + (size_t)nxt.pm * tstepA : cA; const char* nB = has_next ? (const char*)g.Bt + (size_t)nxt.pn * tstepB : cB;
        for (int t = 0; t < nt; t += 2) {
            const bool last = (t == nt - 2);
            const char* a1 = cA + (size_t)(t + 1) * kstep;
            const char* a2 = last ? nA : cA + (size_t)(t + 2) * kstep; const char* b2 = last ? nB : cB + (size_t)(t + 2) * kstep;
            const char* a3 = a2 + kstep; const char* b3 = b2 + kstep;
            if (last && has_next) S.a_ready(nxt);
            if constexpr (SP2) {
            PG8_LDB(B0, 0, 0); PG8_LDB(B1, 0, 1); PG8_SCHED; PG8_LDA(At, 0, 0); PG8_STAGE(PG8_SA(1, 1), a1 + hstepA, voffA);
            PG8_WAIT_V(8); PG8_WAIT_L(0); PG8_BAR; PG8_MMA(0, 0, At, B0); PG8_MMA(0, 1, At, B1); PG8_BAR; PG8_SCHED;
            PG8_LDA(At, 0, 1); PG8_STAGE(PG8_SB(0, 0), b2, voffB); PG8_STAGE(PG8_SB(0, 1), b2 + hstepB, voffB); PG8_STAGE(PG8_SA(0, 0), a2, voffA);
            PG8_WAIT_V(8); PG8_WAIT_L(0); PG8_BAR; PG8_MMA(1, 0, At, B0); PG8_MMA(1, 1, At, B1); PG8_BAR; PG8_SCHED;
            PG8_LDB(B0, 1, 0); PG8_LDB(B1, 1, 1); PG8_SCHED; PG8_LDA(At, 1, 0); PG8_STAGE(PG8_SA(0, 1), a2 + hstepA, voffA);
            PG8_WAIT_V(8); PG8_WAIT_L(0); PG8_BAR; PG8_MMA(0, 0, At, B0); PG8_MMA(0, 1, At, B1); PG8_BAR; PG8_SCHED;
            PG8_LDA(At, 1, 1); PG8_STAGE(PG8_SB(1, 0), b3, voffB); PG8_STAGE(PG8_SB(1, 1), b3 + hstepB, voffB); PG8_STAGE(PG8_SA(1, 0), a3, voffA);
            PG8_WAIT_V(8); PG8_WAIT_L(0); PG8_BAR; PG8_MMA(1, 0, At, B0); PG8_MMA(1, 1, At, B1); PG8_BAR; PG8_SCHED;
            } else {
            PG8_LDB(B0, 0, 0); PG8_SCHED; PG8_LDA(At, 0, 0); PG8_STAGE(PG8_SA(1, 1), a1 + hstepA, voffA);
            PG8_WAIT_L(8); PG8_BAR; PG8_WAIT_L(0); PG8_MMA(0, 0, At, B0); PG8_BAR; PG8_SCHED;
            PG8_LDB(B1, 0, 1); PG8_STAGE(PG8_SB(0, 0), b2, voffB);
            PG8_BAR; PG8_WAIT_L(0); PG8_MMA(0, 1, At, B1); PG8_BAR;
            PG8_LDA(At, 0, 1); PG8_STAGE(PG8_SA(0, 0), a2, voffA);
            PG8_BAR; PG8_WAIT_L(0); PG8_MMA(1, 0, At, B0); PG8_BAR; PG8_SCHED;
            PG8_STAGE(PG8_SB(0, 1), b2 + hstepB, voffB);
            PG8_WAIT_V(6); PG8_BAR; PG8_MMA(1, 1, At, B1); PG8_BAR;
            PG8_LDB(B0, 1, 0); PG8_SCHED; PG8_LDA(At, 1, 0); PG8_STAGE(PG8_SA(0, 1), a2 + hstepA, voffA);
            PG8_WAIT_L(8); PG8_BAR; PG8_WAIT_L(0); PG8_MMA(0, 0, At, B0); PG8_BAR; PG8_SCHED;
            PG8_LDB(B1, 1, 1); PG8_STAGE(PG8_SB(1, 0), b3, voffB);
            PG8_BAR; PG8_WAIT_L(0); PG8_MMA(0, 1, At, B1); PG8_BAR;
            PG8_LDA(At, 1, 1); PG8_STAGE(PG8_SA(1, 0), a3, voffA);
            PG8_BAR; PG8_WAIT_L(0); PG8_MMA(1, 0, At, B0); PG8_BAR; PG8_SCHED;
            PG8_STAGE(PG8_SB(1, 1), b3 + hstepB, voffB);
            PG8_WAIT_V(6); PG8_BAR; PG8_MMA(1, 1, At, B1); PG8_BAR;
            }
        }
        if constexpr (ALIGN_EPI) { if (wr == 0) PG8_BAR; }
        if constexpr (!Epi::AFTER_DRAIN) { E(acc, cur, wr, wc, fr, fq); S.done(cur); }
        if (!has_next) break;
#pragma unroll
        for (int a = 0; a < 2; ++a)
#pragma unroll
            for (int b = 0; b < 2; ++b)
#pragma unroll
                for (int m = 0; m < 4; ++m)
#pragma unroll
                    for (int n = 0; n < 2; ++n) acc[a][b][m][n] = (f32x4){0.f, 0.f, 0.f, 0.f};
        cur = nxt; cA = nA; cB = nB; ++ui;
        if constexpr (ALIGN_EPI) { if (wr == 1) PG8_BAR; }
    }
    PG8_WAIT_V(0);
    if constexpr (!ALIGN_EPI) { if (wr == 0) PG8_BAR; }
    PG8_BAR;
    if constexpr (Epi::AFTER_DRAIN) { E.fused(acc, cur, wr, wc, fr, fq, lds, wid, lane); S.done(cur); }
#undef PG8_SA
#undef PG8_SB
#undef PG8_STAGE
#undef PG8_LDA
#undef PG8_LDB
#undef PG8_MMA
#undef PG8_WAIT_V
#undef PG8_WAIT_L
#undef PG8_BAR
#undef PG8_SCHED
}
}

#define LAS __attribute__((address_space(3)))
typedef unsigned short bf16_t;
typedef short bf16x8 __attribute__((ext_vector_type(8)));
typedef float f32x4 __attribute__((ext_vector_type(4)));
typedef float f32x2 __attribute__((ext_vector_type(2)));
typedef unsigned u32x4 __attribute__((ext_vector_type(4)));
typedef unsigned u32x2 __attribute__((ext_vector_type(2)));

constexpr int M_TOK = 49152, M_PROMPT = 32768, DM = 2048, NPROJ = 6656, NATT = 3072, NRW = 3584, FF = 5632, FF2 = 11264;
constexpr size_t MiB = (size_t)1 << 20;
constexpr size_t WS_BT_IN = 0, WS_BT_OUT = 26 * MiB, WS_BT_GU = 34 * MiB, WS_BT_DOWN = 78 * MiB, WS_BT_W = 100 * MiB, WS_BT_A = 100 * MiB + 512 * 1024, WS_BT_G = 101 * MiB,
                 WS_RSTD1 = 102 * MiB, WS_SS2 = 102 * MiB + 256 * 1024, WS_SS3 = 102 * MiB + 512 * 1024, WS_SSATT = 103 * MiB,
                 WS_R1 = 112 * MiB  , WS_R2 = 448 * MiB  , WS_R3 = 736 * MiB  ,
                 WS_OMD = WS_R2, WS_G = WS_R2 + 192 * MiB, WS_X1B = WS_R1, WS_H = 304 * MiB, WS_SA = 107 * MiB  , WS_QB = 928 * MiB  , WS_END = 992 * MiB;
constexpr size_t OUT_XB = 0, OUT_YF = 0, OUT_YB = 96 * MiB, OUT_A = 192 * MiB;
constexpr int LDS_BYTES = 136 * 1024;
constexpr int NPH = 13;

__device__ __forceinline__ int opaque_tid() { int t = threadIdx.x; asm volatile("" : "+v"(t)); return t; }
struct Args { const float* in[24]; float* out; unsigned char* ws; int ph_lo, ph_hi; };

__device__ __forceinline__ float bf_lo(unsigned w) { return __uint_as_float(w << 16); }
__device__ __forceinline__ float bf_hi(unsigned w) { return __uint_as_float(w & 0xffff0000u); }
__device__ __forceinline__ unsigned pk_bf(float lo, float hi) { return pg8::cvt_pk_bf16(lo, hi); }
__device__ __forceinline__ float wave_sum(float v) { v += __shfl_xor(v, 1); v += __shfl_xor(v, 2); v += __shfl_xor(v, 4); v += __shfl_xor(v, 8); v += __shfl_xor(v, 16); v += __shfl_xor(v, 32); return v; }
__device__ __forceinline__ float half_sum(float v) { v += __shfl_xor(v, 1); v += __shfl_xor(v, 2); v += __shfl_xor(v, 4); v += __shfl_xor(v, 8); v += __shfl_xor(v, 16); return v; }
template <int CTRL> __device__ __forceinline__ float dpp_add(float x) { const int v = __builtin_amdgcn_update_dpp(0, __float_as_int(x), CTRL, 0xF, 0xF, false); return x + __int_as_float(v); }
template <int LPR> __device__ __forceinline__ float row_sum(float x) {
    x = dpp_add<0xB1>(x); x = dpp_add<0x4E>(x); x = dpp_add<0x141>(x); if (LPR == 16) x = dpp_add<0x140>(x); return x;
}

__device__ __forceinline__ void tr_tile(LAS float* tile, const float* src, int ldsrc, int nvalid, const float* sc, int sc_n, bf16_t* dst, int lddst, int k0, int n0, int drow0, int tid) {
    const int kk = tid >> 4, n4 = (tid & 15) * 4;
#pragma unroll
    for (int p = 0; p < 2; ++p) { const int k = kk + 32 * p, n = n0 + n4; f32x4 v = (f32x4){0.f, 0.f, 0.f, 0.f};
        if (n < nvalid) v = *(const f32x4*)(src + (size_t)(k0 + k) * ldsrc + n);
        const float s = (sc != nullptr && (k0 + k) < sc_n) ? sc[k0 + k] : 1.0f;
        tile[k * 65 + n4 + 0] = v[0] * s; tile[k * 65 + n4 + 1] = v[1] * s; tile[k * 65 + n4 + 2] = v[2] * s; tile[k * 65 + n4 + 3] = v[3] * s; }
    __syncthreads();
    const int nn = tid >> 3, kc = (tid & 7) * 8; float e[8];
#pragma unroll
    for (int j = 0; j < 8; ++j) e[j] = tile[(kc + j) * 65 + nn];
    u32x4 w; w.x = pk_bf(e[0], e[1]); w.y = pk_bf(e[2], e[3]); w.z = pk_bf(e[4], e[5]); w.w = pk_bf(e[6], e[7]);
    *(u32x4*)(dst + (size_t)(drow0 + nn) * lddst + k0 + kc) = w;
    __syncthreads();
}

__device__ __forceinline__ void late_weights(const Args& a, LAS unsigned char* lds, int vb, int nvb) {
    const int tid = opaque_tid(); unsigned char* ws = a.ws; LAS float* tile = (LAS float*)lds;
    bf16_t* Bt_out = (bf16_t*)(ws + WS_BT_OUT); bf16_t* Bt_gu = (bf16_t*)(ws + WS_BT_GU); bf16_t* Bt_down = (bf16_t*)(ws + WS_BT_DOWN);
    for (int job = 3328 + vb; job < 12800; job += nvb) {
        const float* src; const float* sc; bf16_t* dst; int ldsrc, scn, lddst, k0, n0, d0;
        if (job < 4352) { const int j = job - 3328, kt = j / 32, nt = j % 32; src = a.in[18]; ldsrc = 2048; sc = a.in[5]; scn = 1024; dst = Bt_out; lddst = 2048; k0 = kt * 64; n0 = nt * 64; d0 = n0; }
        else if (job < 9984) { const int up = job >= 7168, j = job - (up ? 7168 : 4352), kt = j / 88, nt = j % 88; src = up ? a.in[21] : a.in[20]; ldsrc = 5632; sc = a.in[19]; scn = 2048; dst = Bt_gu; lddst = 2048; k0 = kt * 64; n0 = nt * 64; d0 = (n0 / 128) * 256 + (up ? 128 : 0) + (n0 % 128); }
        else { const int j = job - 9984, kt = j / 32, nt = j % 32; src = a.in[22]; ldsrc = 2048; sc = nullptr; scn = 0; dst = Bt_down; lddst = 5632; k0 = kt * 64; n0 = nt * 64; d0 = n0; }
        tr_tile(tile, src, ldsrc, ldsrc, sc, scn, dst, lddst, k0, n0, d0, tid);
    }
}
__device__ __forceinline__ void p0_prologue(const Args& a, LAS unsigned char* lds) {
    const int tid = opaque_tid(), lane = tid & 63, wave = tid >> 6, G = gridDim.x, bx = blockIdx.x;
    unsigned char* ws = a.ws;
    LAS float* tile = (LAS float*)lds;
    bf16_t* Bt_in = (bf16_t*)(ws + WS_BT_IN); bf16_t* Bt_out = (bf16_t*)(ws + WS_BT_OUT); bf16_t* Bt_gu = (bf16_t*)(ws + WS_BT_GU); bf16_t* Bt_down = (bf16_t*)(ws + WS_BT_DOWN);
    for (int job = bx; job < 12800; job += G) {
        if (job < 3328) { const int kt = job / 104, nt = job % 104; tr_tile(tile, a.in[3], 6560, 6560, a.in[2], 2048, Bt_in, 2048, kt * 64, nt * 64, nt * 64, tid); }
        else if (job < 4352) { const int j = job - 3328, kt = j / 32, nt = j % 32; tr_tile(tile, a.in[18], 2048, 2048, a.in[5], 1024, Bt_out, 2048, kt * 64, nt * 64, nt * 64, tid); }
        else if (job < 7168) { const int j = job - 4352, kt = j / 88, nt = j % 88, n0 = nt * 64; tr_tile(tile, a.in[20], 5632, 5632, a.in[19], 2048, Bt_gu, 2048, kt * 64, n0, (n0 / 128) * 256 + (n0 % 128), tid); }
        else if (job < 9984) { const int j = job - 7168, kt = j / 88, nt = j % 88, n0 = nt * 64; tr_tile(tile, a.in[21], 5632, 5632, a.in[19], 2048, Bt_gu, 2048, kt * 64, n0, (n0 / 128) * 256 + 128 + (n0 % 128), tid); }
        else { const int j = job - 9984, kt = j / 32, nt = j % 32; tr_tile(tile, a.in[22], 2048, 2048, nullptr, 0, Bt_down, 5632, kt * 64, nt * 64, nt * 64, tid); }
    }
    bf16_t* Bt_w = (bf16_t*)(ws + WS_BT_W); bf16_t* Bt_a = (bf16_t*)(ws + WS_BT_A); bf16_t* Bt_g = (bf16_t*)(ws + WS_BT_G);
    float* ss2 = (float*)(ws + WS_SS2); float* ss3 = (float*)(ws + WS_SS3);
    const float* w2 = a.in[9]; const float* a2 = a.in[11]; const float* g2 = a.in[12];
    for (int idx = bx * 512 + tid; idx < 2048 * 128; idx += G * 512) { const int n = idx >> 7, k = idx & 127, e = n >> 10, c = n & 1023, e2 = k >> 6, l = k & 63;
        const float wv = (e == e2) ? w2[(size_t)(e * 64 + l) * 1024 + c] : 0.f, av = (e == e2) ? a2[(size_t)(e * 64 + l) * 1024 + c] : 0.f;
        Bt_w[idx] = (bf16_t)(pk_bf(wv, 0.f) & 0xffffu); Bt_a[idx] = (bf16_t)(pk_bf(av, 0.f) & 0xffffu); }
    for (int idx = bx * 512 + tid; idx < 1024 * 256; idx += G * 512) { const int n = idx >> 8, k = idx & 255; const float gv = (k < 160) ? g2[(size_t)k * 1024 + n] : 0.f; Bt_g[idx] = (bf16_t)(pk_bf(gv, 0.f) & 0xffffu); }
    for (int idx = bx * 512 + tid; idx < M_TOK; idx += G * 512) { ss2[idx] = 0.f; ss3[idx] = 0.f; }
    bf16_t* xb = (bf16_t*)((unsigned char*)a.out + OUT_XB); float* rstd1 = (float*)(ws + WS_RSTD1);
    for (int row = bx * 8 + wave; row < M_TOK; row += G * 8) {
        const float* xr = row < M_PROMPT ? a.in[0] + (size_t)row * DM : a.in[1] + (size_t)(row - M_PROMPT) * DM;
        f32x4 v[8]; float ss = 0.f;
#pragma unroll
        for (int i = 0; i < 8; ++i) { v[i] = *(const f32x4*)(xr + i * 256 + lane * 4); ss += (v[i][0] * v[i][0] + v[i][1] * v[i][1]) + (v[i][2] * v[i][2] + v[i][3] * v[i][3]); }
        ss = wave_sum(ss);
        if (lane == 0) rstd1[row] = rsqrtf(ss * (1.0f / 2048.0f) + 1e-6f);
#pragma unroll
        for (int i = 0; i < 8; ++i) { u32x2 w; w.x = pk_bf(v[i][0], v[i][1]); w.y = pk_bf(v[i][2], v[i][3]); *(u32x2*)(xb + (size_t)row * DM + i * 256 + lane * 4) = w; }
    }
}

__device__ __forceinline__ void p2_lora_in(const Args& a) {
    const bf16_t* rw = (const bf16_t*)(a.ws + WS_R1); bf16_t* cat = (bf16_t*)(a.ws + WS_R3);
    const float* mup = a.in[6]; const float* mun = a.in[7];
    for (int idx = blockIdx.x * 512 + opaque_tid(); idx < M_TOK * 256; idx += gridDim.x * 512) {
        const int row = idx >> 8, c = (idx & 255) * 2; unsigned outw = 0u;
        if (c < 416) {
            const int sc = 3072 + c; const int t = row < M_PROMPT ? (row & 8191) : row - M_PROMPT, T = row < M_PROMPT ? 8192 : 16384;
            const unsigned pc = *(const unsigned*)(rw + (size_t)row * NRW + sc);
            const unsigned pp = t > 0 ? *(const unsigned*)(rw + (size_t)(row - 1) * NRW + sc) : 0u;
            const unsigned pn = t < T - 1 ? *(const unsigned*)(rw + (size_t)(row + 1) * NRW + sc) : 0u;
            float u0 = bf_lo(pc), u1 = bf_hi(pc);
            u0 = u0 + mup[sc] * (bf_lo(pp) - u0) + mun[sc] * (bf_lo(pn) - u0);
            u1 = u1 + mup[sc + 1] * (bf_hi(pp) - u1) + mun[sc + 1] * (bf_hi(pn) - u1);
            if (c < 128) { u0 = tanhf(u0); u1 = tanhf(u1); } else if (c >= 256) { u0 = pg8::sigmoidf_(u0); u1 = pg8::sigmoidf_(u1); }
            outw = pk_bf(u0, u1);
        }
        *(unsigned*)(cat + (size_t)row * DM + 1024 + c) = outw;
    }
}
__device__ __forceinline__ void p2_na(const Args& a, LAS unsigned char* lds) {
    const int tid = opaque_tid(), lane = tid & 63, wave = __builtin_amdgcn_readfirstlane(tid >> 6), l16 = lane & 15, g = lane >> 4;
    const bf16_t* pa = (const bf16_t*)(a.ws + WS_R2); bf16_t* cat = (bf16_t*)(a.ws + WS_R3); float* ssatt = (float*)(a.ws + WS_SSATT);
    const float* rpb = a.in[4];
    LAS unsigned* Vt = (LAS unsigned*)lds;
    LAS float* BL = (LAS float*)(lds + 128 * 260 * 4);
    const int hh = wave >> 2, cw = wave & 3, cb = cw == 0 ? 0 : (cw == 1 ? 8 : (cw == 2 ? 24 : 32));
    const int c = 16 * cw + l16; int cs = c - 8; cs = cs < 0 ? 0 : (cs > 48 ? 48 : cs);
    float madd[2][4]; const LAS float* bp[2][4];
#pragma unroll
    for (int hf = 0; hf < 2; ++hf)
#pragma unroll
        for (int ii = 0; ii < 4; ++ii) { const int kc = cb + 16 * hf + 4 * g + ii; madd[hf][ii] = ((kc >= cs) && (kc < cs + 16)) ? 0.f : -1e30f; bp[hf][ii] = BL + 32 + hh * 248 + (kc - c + 15); }
    const int koff = (cb + l16) * NATT + 8 * g, qoff = (16 * cw + l16) * NATT + 8 * g;
    const LAS unsigned* pA[4]; const LAS unsigned* pB[4];
#pragma unroll
    for (int dt = 0; dt < 4; ++dt) { const int d = 16 * dt + l16, sw = 4 * ((d >> 3) & 7), cc = (cb >> 1) + 2 * g; pA[dt] = Vt + (hh * 64 + d) * 260 + (cc ^ sw); pB[dt] = Vt + (hh * 64 + d) * 260 + ((cc + 8) ^ sw); }
    for (int unit = blockIdx.x; unit < 6144; unit += gridDim.x) {
        const int hp = unit & 7, sr = unit >> 3;
        int r, rows, base_tok;
        if (sr < 512) { r = sr & 127; rows = 128; base_tok = (sr >> 7) * 8192; } else { r = sr - 512; rows = 256; base_tok = M_PROMPT; }
        int r0 = r - 4; r0 = r0 < 0 ? 0 : (r0 > rows - 8 ? rows - 8 : r0);
        const int t0 = base_tok + r0 * 64, tq = base_tok + r * 64;
        bf16x8 q0, q1, kf[16][2];
        {
            const int vh = tid >> 8, q = tid & 255, j = q & 7, pl = q >> 3;
            const bf16_t* vsrc = pa + (size_t)t0 * NATT + 2048 + (2 * hp + vh) * 64 + 8 * j;
            u32x4 x[8], y[8];
#pragma unroll
            for (int it = 0; it < 8; ++it) { const int pi = it * 32 + pl; x[it] = *(const u32x4*)(vsrc + (size_t)(2 * pi) * NATT); y[it] = *(const u32x4*)(vsrc + (size_t)(2 * pi + 1) * NATT); }
            {
                const bf16_t* qb = pa + (size_t)tq * NATT + (2 * hp + hh) * 64; const bf16_t* kb = pa + (size_t)t0 * NATT + 1024 + (2 * hp + hh) * 64;
                q0 = *(const bf16x8*)(qb + qoff); q1 = *(const bf16x8*)(qb + qoff + 32);
#pragma unroll
                for (int kt = 0; kt < 16; ++kt) { const bf16_t* kp = kb + (size_t)(64 * (kt >> 1) + 16 * (kt & 1)) * NATT + koff; kf[kt][0] = *(const bf16x8*)kp; kf[kt][1] = *(const bf16x8*)(kp + 32); }
            }
            __builtin_amdgcn_sched_barrier(0);
            if (tid < 496) { const int bh = tid / 248, rem = tid % 248, bi = rem / 31, dc = rem % 31; BL[32 + tid] = rpb[((2 * hp + bh) * 15 + (r0 + bi - r + 7)) * 31 + dc] * 1.44269504f; }
            else if (tid < 560) { const int z = tid - 496; BL[z < 32 ? z : 496 + z] = 0.f; }
#pragma unroll
            for (int it = 0; it < 8; ++it) { const int col = (it * 32 + pl) ^ (4 * j);
#pragma unroll
                for (int e = 0; e < 4; ++e) { Vt[(vh * 64 + 8 * j + 2 * e) * 260 + col] = (x[it][e] & 0xffffu) | (y[it][e] << 16); Vt[(vh * 64 + 8 * j + 2 * e + 1) * 260 + col] = (x[it][e] >> 16) | (y[it][e] & 0xffff0000u); } }
        }
        __syncthreads();
        {
            const int h = 2 * hp + hh;
            f32x4 s[16];
#pragma unroll
            for (int kt = 0; kt < 16; ++kt) { f32x4 acc = (f32x4){0.f, 0.f, 0.f, 0.f};
                acc = __builtin_amdgcn_mfma_f32_16x16x32_bf16(kf[kt][0], q0, acc, 0, 0, 0);
                acc = __builtin_amdgcn_mfma_f32_16x16x32_bf16(kf[kt][1], q1, acc, 0, 0, 0);
                s[kt] = acc; }
            float mx = -1e30f;
#pragma unroll
            for (int kt = 0; kt < 16; ++kt) { const int i = kt >> 1, hf = kt & 1;
#pragma unroll
                for (int ii = 0; ii < 4; ++ii) { const float v = s[kt][ii] * (0.125f * 1.44269504f) + (bp[hf][ii][i * 31] + madd[hf][ii]); s[kt][ii] = v; mx = fmaxf(mx, v); } }
            mx = fmaxf(mx, __shfl_xor(mx, 16)); mx = fmaxf(mx, __shfl_xor(mx, 32));
            float sum = 0.f;
#pragma unroll
            for (int kt = 0; kt < 16; ++kt)
#pragma unroll
                for (int ii = 0; ii < 4; ++ii) { const float p = __builtin_amdgcn_exp2f(s[kt][ii] - mx); s[kt][ii] = p; sum += p; }
            sum += __shfl_xor(sum, 16); sum += __shfl_xor(sum, 32);
            f32x4 o[4];
#pragma unroll
            for (int dt = 0; dt < 4; ++dt) o[dt] = (f32x4){0.f, 0.f, 0.f, 0.f};
#pragma unroll
            for (int i = 0; i < 8; ++i) {
                u32x4 pw; pw.x = pk_bf(s[2 * i][0], s[2 * i][1]); pw.y = pk_bf(s[2 * i][2], s[2 * i][3]); pw.z = pk_bf(s[2 * i + 1][0], s[2 * i + 1][1]); pw.w = pk_bf(s[2 * i + 1][2], s[2 * i + 1][3]);
                const bf16x8 pf = __builtin_bit_cast(bf16x8, pw);
#pragma unroll
                for (int dt = 0; dt < 4; ++dt) {
                    const u32x2 va = *(const LAS u32x2*)(pA[dt] + 32 * i), vb = *(const LAS u32x2*)(pB[dt] + 32 * i);
                    u32x4 vw; vw.x = va.x; vw.y = va.y; vw.z = vb.x; vw.w = vb.y;
                    o[dt] = __builtin_amdgcn_mfma_f32_16x16x32_bf16(__builtin_bit_cast(bf16x8, vw), pf, o[dt], 0, 0, 0); }
            }
            const float inv = 1.0f / sum; float sq = 0.f;
            bf16_t* op = cat + (size_t)(tq + 16 * cw + l16) * DM + h * 64 + 4 * g;
#pragma unroll
            for (int dt = 0; dt < 4; ++dt) { const f32x4 v = o[dt] * inv; sq += (v[0] * v[0] + v[1] * v[1]) + (v[2] * v[2] + v[3] * v[3]);
                u32x2 w; w.x = pk_bf(v[0], v[1]); w.y = pk_bf(v[2], v[3]); *(u32x2*)(op + 16 * dt) = w; }
            sq += __shfl_xor(sq, 16); sq += __shfl_xor(sq, 32);
            if (g == 0) ssatt[(size_t)(tq + 16 * cw + l16) * 16 + h] = sq;
        }
        __syncthreads();
    }
}
constexpr int SC_TC = 16;
template <int LPR, int RPL> __device__ __forceinline__ void scan_chain(const Args& a, LAS unsigned char* lds, int e, int tok_base, int T, int h, int rowbase, int s0, int nsteps, int mode) {
    constexpr int NE = 64 / LPR, NP = NE / 2, GPW = 64 / LPR, RPW = RPL * GPW, NROW = 4 * RPW, YST = NROW * LPR;
    const int tid = opaque_tid(), lane = tid & 63, wave = tid >> 6;
    LAS float* buf = (LAS float*)lds;
    LAS float* ypart = (LAS float*)(lds + 2 * SC_TC * 6 * 64 * 4);
    const int NC = nsteps / SC_TC;
    if (wave >= 4) {
        const int lt = tid - 256, ts0 = lt >> 5, cp = lt & 31, c0 = h * 64 + 2 * cp;
        const bf16_t* rw = (const bf16_t*)(a.ws + WS_R1); const bf16_t* omd = (const bf16_t*)(a.ws + WS_OMD); const bf16_t* ab = (const bf16_t*)((const unsigned char*)a.out + OUT_A);
        bf16_t* Y = (bf16_t*)((unsigned char*)a.out + (e ? OUT_YB : OUT_YF)); float* Qb = (float*)(a.ws + WS_QB) + (size_t)e * 8192 * 1024;
        f32x2 mp2[3], mn2[3], cm2[3];
#pragma unroll
        for (int q = 0; q < 3; ++q) { mp2[q] = *(const f32x2*)(a.in[6] + q * 1024 + c0); mn2[q] = *(const f32x2*)(a.in[7] + q * 1024 + c0); cm2[q] = (f32x2){1.0f, 1.0f} - mp2[q] - mn2[q]; }
        const f32x2 kkc2 = *(const f32x2*)(a.in[13] + c0), ka2 = *(const f32x2*)(a.in[14] + c0), omka2 = (f32x2){1.0f, 1.0f} - ka2;
        unsigned R[2][11];
        const bool yrow = (2 * cp >= rowbase) && (2 * cp < rowbase + NROW);
#define SC_LOAD(chunk) do { _Pragma("unroll") for (int sl = 0; sl < 2; ++sl) { const int s_ = s0 + (chunk) * SC_TC + 2 * ts0 + sl; const int t_ = e ? (T - 1 - s_) : s_; const size_t tok_ = (size_t)(tok_base + t_); \
        const bf16_t* p_ = rw + tok_ * NRW + c0; \
        _Pragma("unroll") for (int q = 0; q < 3; ++q) { R[sl][3 * q + 1] = *(const unsigned*)(p_ + q * 1024); \
            R[sl][3 * q + 0] = t_ > 0 ? *(const unsigned*)(p_ - NRW + q * 1024) : 0u; R[sl][3 * q + 2] = t_ < T - 1 ? *(const unsigned*)(p_ + NRW + q * 1024) : 0u; } \
        R[sl][9] = *(const unsigned*)(omd + tok_ * 2048 + e * 1024 + c0); R[sl][10] = *(const unsigned*)(ab + tok_ * 2048 + e * 1024 + c0); } } while (0)
#define SC_P2(x) ((f32x2){bf_lo(x), bf_hi(x)})
#define SC_MIX2(sl, q) (cm2[q] * SC_P2(R[sl][3 * (q) + 1]) + mp2[q] * SC_P2(R[sl][3 * (q)]) + mn2[q] * SC_P2(R[sl][3 * (q) + 2]))
#define SC_STORE(nb) do { f32x2 r_[2], k_[2], v_[2], kk_[2], a_[2], w_[2]; \
        _Pragma("unroll") for (int sl = 0; sl < 2; ++sl) { r_[sl] = SC_MIX2(sl, 0); k_[sl] = SC_MIX2(sl, 1); v_[sl] = SC_MIX2(sl, 2); \
            const f32x2 q_ = k_[sl] * kkc2; float n2_ = row_sum<16>(q_.x * q_.x + q_.y * q_.y); n2_ += __shfl_xor(n2_, 16); const float in_ = rsqrtf(fmaxf(n2_, 1e-24f)); \
            kk_[sl] = q_ * in_; a_[sl] = SC_P2(R[sl][10]); w_[sl] = (f32x2){1.0f, 1.0f} - SC_P2(R[sl][9]); } \
          \
        const f32x2 p2_ = w_[0] * w_[1]; f32x2 po_; po_.x = __shfl_xor(p2_.x, 32); po_.y = __shfl_xor(p2_.y, 32); \
        const f32x2 base_ = (lane & 32) ? po_ : (f32x2){1.0f, 1.0f}; \
        f32x2 gp_[2], g_[2]; gp_[0] = base_; g_[0] = base_ * w_[0]; gp_[1] = g_[0]; g_[1] = g_[0] * w_[1]; \
        _Pragma("unroll") for (int sl = 0; sl < 2; ++sl) { LAS float* b_ = buf + ((nb) * SC_TC + 2 * ts0 + sl) * 6 * 64 + 2 * cp; \
            const f32x2 ig_ = (f32x2){__builtin_amdgcn_rcpf(g_[sl].x), __builtin_amdgcn_rcpf(g_[sl].y)}; \
            *(LAS f32x2*)(b_ + 0 * 64) = -(kk_[sl] * gp_[sl]); \
            *(LAS f32x2*)(b_ + 1 * 64) = g_[sl]; \
            *(LAS f32x2*)(b_ + 2 * 64) = k_[sl] * (omka2 + a_[sl] * ka2) * ig_; \
            *(LAS f32x2*)(b_ + 3 * 64) = kk_[sl] * a_[sl] * ig_; \
            *(LAS f32x2*)(b_ + 4 * 64) = r_[sl] * g_[sl]; \
            *(LAS f32x2*)(b_ + 5 * 64) = (mode == 1) ? (f32x2){0.f, 0.f} : v_[sl]; } } while (0)
#define SC_YOUT(chunk) do { if (yrow) { _Pragma("unroll") for (int sl = 0; sl < 2; ++sl) { const int sr_ = (chunk) * SC_TC + 2 * ts0 + sl, s_ = s0 + sr_; const int t_ = e ? (T - 1 - s_) : s_; \
        const LAS float* y_ = ypart + (((chunk) & 1) * SC_TC + 2 * ts0 + sl) * YST + (2 * cp - rowbase) * LPR; float ya_ = 0.f, yb_ = 0.f; \
        _Pragma("unroll") for (int j = 0; j < LPR; j += 4) { const f32x4 u_ = *(const LAS f32x4*)(y_ + j), w_ = *(const LAS f32x4*)(y_ + LPR + j); ya_ += (u_[0] + u_[1]) + (u_[2] + u_[3]); yb_ += (w_[0] + w_[1]) + (w_[2] + w_[3]); } \
        if (mode == 1) *(f32x2*)(Qb + (size_t)sr_ * 1024 + c0) = (f32x2){ya_, yb_}; \
        else *(unsigned*)(Y + (size_t)(tok_base + t_) * 1024 + c0) = pk_bf(ya_, yb_); } } } while (0)
        SC_LOAD(0); SC_STORE(0);
        __syncthreads();
        for (int c = 0; c < NC; ++c) {
            if (c + 1 < NC) SC_LOAD(c + 1);
            if (c > 0) SC_YOUT(c - 1);
            if (c + 1 < NC) SC_STORE((c + 1) & 1);
            __syncthreads();
        }
        SC_YOUT(NC - 1);
#undef SC_LOAD
#undef SC_P2
#undef SC_MIX2
#undef SC_STORE
#undef SC_YOUT
    } else {
        const int part = lane % LPR, rloc = lane / LPR;
        f32x2 S[RPL][NP];
#pragma unroll
        for (int rr = 0; rr < RPL; ++rr)
#pragma unroll
            for (int p = 0; p < NP; ++p) { const int row_ = rowbase + wave * RPW + rr * GPW + rloc, col_ = part * NE + 2 * p; S[rr][p] = (f32x2){(mode == 1 && col_ == row_) ? 1.f : 0.f, (mode == 1 && col_ + 1 == row_) ? 1.f : 0.f}; }
        __syncthreads();
        for (int c = 0; c < NC; ++c) {
            const LAS float* bc = buf + (c & 1) * SC_TC * 384 + part * NE;
            const LAS float* vc = buf + (c & 1) * SC_TC * 384 + 320 + rowbase + wave * RPW + rloc;
            LAS float* yp = ypart + (c & 1) * SC_TC * YST + wave * (RPL * 64) + lane;
            f32x4 nx[5][NE / 4]; float nv[RPL];
#pragma unroll
            for (int q = 0; q < 5; ++q)
#pragma unroll
                for (int j = 0; j < NE / 4; ++j) nx[q][j] = *(const LAS f32x4*)(bc + q * 64 + 4 * j);
#pragma unroll
            for (int rr = 0; rr < RPL; ++rr) nv[rr] = vc[rr * GPW];
#pragma unroll
            for (int st = 0; st < SC_TC; ++st) {
                f32x2 z[NP], w[NP], kd[NP], bq[NP], rv[NP]; float vv[RPL];
#pragma unroll
                for (int j = 0; j < NE / 4; ++j) { z[2 * j] = (f32x2){nx[0][j][0], nx[0][j][1]}; z[2 * j + 1] = (f32x2){nx[0][j][2], nx[0][j][3]}; w[2 * j] = (f32x2){nx[1][j][0], nx[1][j][1]}; w[2 * j + 1] = (f32x2){nx[1][j][2], nx[1][j][3]};
                    kd[2 * j] = (f32x2){nx[2][j][0], nx[2][j][1]}; kd[2 * j + 1] = (f32x2){nx[2][j][2], nx[2][j][3]}; bq[2 * j] = (f32x2){nx[3][j][0], nx[3][j][1]}; bq[2 * j + 1] = (f32x2){nx[3][j][2], nx[3][j][3]};
                    rv[2 * j] = (f32x2){nx[4][j][0], nx[4][j][1]}; rv[2 * j + 1] = (f32x2){nx[4][j][2], nx[4][j][3]}; }
#pragma unroll
                for (int rr = 0; rr < RPL; ++rr) vv[rr] = nv[rr];
                if (st + 1 < SC_TC) {
#pragma unroll
                    for (int q = 0; q < 5; ++q)
#pragma unroll
                        for (int j = 0; j < NE / 4; ++j) if (q != 1 || ((st + 1) & 3) == 3) nx[q][j] = *(const LAS f32x4*)(bc + (st + 1) * 384 + q * 64 + 4 * j);
#pragma unroll
                    for (int rr = 0; rr < RPL; ++rr) nv[rr] = vc[(st + 1) * 384 + rr * GPW];
                }
#pragma unroll
                for (int rr = 0; rr < RPL; ++rr) {
                    f32x2 acc = S[rr][0] * z[0];
#pragma unroll
                    for (int p = 1; p < NP; ++p) acc = S[rr][p] * z[p] + acc;
                    const float sz = row_sum<LPR>(acc.x + acc.y);
                    const f32x2 sz2 = (f32x2){sz, sz}, v2 = (f32x2){vv[rr], vv[rr]};
                    f32x2 ya = (f32x2){0.f, 0.f};
#pragma unroll
                    for (int p = 0; p < NP; ++p) { const f32x2 t = v2 * kd[p] + S[rr][p]; S[rr][p] = sz2 * bq[p] + t; ya = S[rr][p] * rv[p] + ya; }
                    yp[st * YST + rr * 64] = ya.x + ya.y;
                    if ((st & 3) == 3) {
#pragma unroll
                        for (int p = 0; p < NP; ++p) S[rr][p] = S[rr][p] * w[p]; }
                }
            }
            __syncthreads();
        }
        if (mode == 2) { float* SA = (float*)(a.ws + WS_SA) + (size_t)(e * 16 + h) * 4096;
#pragma unroll
            for (int rr = 0; rr < RPL; ++rr)
#pragma unroll
                for (int p = 0; p < NP; ++p) *(f32x2*)(SA + (rowbase + wave * RPW + rr * GPW + rloc) * 64 + part * NE + 2 * p) = S[rr][p]; }
    }
    __syncthreads();
}
__device__ __forceinline__ void p4_scan(const Args& a, LAS unsigned char* lds) {
    for (int task = blockIdx.x; task < 224; task += gridDim.x) {
        int e, h, tok_base, T, s0, mode;
        if (task < 128) { const int b = task >> 5; h = (task >> 1) & 15; e = task & 1; tok_base = b * 8192; T = 8192; s0 = 0; mode = 0; }
        else { const int j = task - 128, kind = j >> 5, eh = j & 31; e = eh & 1; h = eh >> 1; tok_base = M_PROMPT; T = 16384; s0 = kind == 0 ? 0 : 8192; mode = kind == 0 ? 2 : (kind == 1 ? 0 : 1); }
        scan_chain<8, 2>(a, lds, e, tok_base, T, h, 0, s0, 8192, mode);
    }
}
__device__ __forceinline__ void p6_corr(const Args& a, LAS unsigned char* lds) {
    const int tid = opaque_tid(), lane = tid & 63, wave = __builtin_amdgcn_readfirstlane(tid >> 6);
    LAS float* qt = (LAS float*)lds;
    for (int unit = blockIdx.x; unit < 256; unit += gridDim.x) {
        const int eh = unit >> 3, chunk = unit & 7, e = eh & 1, h = eh >> 1;
        const float* sa = (const float*)(a.ws + WS_SA) + ((size_t)(e * 16 + h) * 64 + lane) * 64;
        f32x4 sv[16];
#pragma unroll
        for (int j = 0; j < 16; ++j) sv[j] = *(const f32x4*)(sa + 4 * j);
        bf16_t* Y = (bf16_t*)((unsigned char*)a.out + (e ? OUT_YB : OUT_YF));
        const float* qb = (const float*)(a.ws + WS_QB) + (size_t)e * 8192 * 1024 + h * 64;
        for (int sub = 0; sub < 8; ++sub) {
            const int sbase = chunk * 1024 + sub * 128;
            f32x4 ql[4];
#pragma unroll
            for (int k = 0; k < 4; ++k) { const int idx = tid + 512 * k; ql[k] = *(const f32x4*)(qb + (size_t)(sbase + (idx >> 4)) * 1024 + (idx & 15) * 4); }
            unsigned short yv[16];
#pragma unroll
            for (int k = 0; k < 16; ++k) { const int sidx = sbase + wave * 16 + k; const int t = e ? (16384 - 1 - (8192 + sidx)) : (8192 + sidx); yv[k] = Y[(size_t)(M_PROMPT + t) * 1024 + h * 64 + lane]; }
#pragma unroll
            for (int k = 0; k < 4; ++k) { const int idx = tid + 512 * k; *(LAS f32x4*)(qt + (idx >> 4) * 64 + (idx & 15) * 4) = ql[k]; }
            __syncthreads();
#pragma unroll 4
            for (int k = 0; k < 16; ++k) { const int sidx = sbase + wave * 16 + k; const int t = e ? (16384 - 1 - (8192 + sidx)) : (8192 + sidx);
                const LAS float* q = qt + (wave * 16 + k) * 64; f32x4 acc = (f32x4){0.f, 0.f, 0.f, 0.f};
#pragma unroll
                for (int j = 0; j < 16; ++j) acc += sv[j] * *(const LAS f32x4*)(q + 4 * j);
                const float y = __uint_as_float((unsigned)yv[k] << 16) + ((acc[0] + acc[1]) + (acc[2] + acc[3]));
                Y[(size_t)(M_PROMPT + t) * 1024 + h * 64 + lane] = (bf16_t)(pk_bf(y, 0.f) & 0xffffu); }
            __syncthreads();
        }
    }
}
struct PostRegs { unsigned X[6][3], A0[4], A1[4], GW[4], YF[4], YB[4], AT[4]; float SS[4]; };
struct PostCtx { const bf16_t* rw; const bf16_t* ab; const bf16_t* gb; const bf16_t* yf; const bf16_t* yb; bf16_t* cat; const float* ssatt; int tid, c0; f32x2 mp2[3], mn2[3], cm2[3], ka2, rk2, lw2, lb2; };
__device__ __forceinline__ void post_load(PostRegs& R, const PostCtx& C, int m0) {
    const int t0 = m0 < M_PROMPT ? (m0 & 8191) : m0 - M_PROMPT, T = m0 < M_PROMPT ? 8192 : 16384;
#pragma unroll
    for (int j = 0; j < 6; ++j) { const int t = t0 - 1 + j; const bool ok = (t >= 0) && (t < T); const bf16_t* p = C.rw + (size_t)(m0 - 1 + j) * NRW + C.c0;
#pragma unroll
        for (int q = 0; q < 3; ++q) R.X[j][q] = ok ? *(const unsigned*)(p + q * 1024) : 0u; }
#pragma unroll
    for (int u = 0; u < 4; ++u) { const size_t m = (size_t)(m0 + u);
        R.A0[u] = *(const unsigned*)(C.ab + m * 2048 + C.c0); R.A1[u] = *(const unsigned*)(C.ab + m * 2048 + 1024 + C.c0); R.GW[u] = *(const unsigned*)(C.gb + m * 1024 + C.c0);
        R.YF[u] = *(const unsigned*)(C.yf + m * 1024 + C.c0); R.YB[u] = *(const unsigned*)(C.yb + m * 1024 + C.c0); R.AT[u] = *(const unsigned*)(C.cat + m * DM + 2 * C.tid);
        R.SS[u] = C.ssatt[m * 16 + (C.tid & 15)]; }
}
#define P5_P2(x) ((f32x2){bf_lo(x), bf_hi(x)})
__device__ __forceinline__ void post_compute(const PostRegs& R, const PostCtx& C, int m0) {
    float s1[4], s2[4], s3[4]; f32x2 yv[4], vm[4];
#pragma unroll
    for (int u = 0; u < 4; ++u) {
        const f32x2 r_ = C.cm2[0] * P5_P2(R.X[u + 1][0]) + C.mp2[0] * P5_P2(R.X[u][0]) + C.mn2[0] * P5_P2(R.X[u + 2][0]);
        const f32x2 k_ = C.cm2[1] * P5_P2(R.X[u + 1][1]) + C.mp2[1] * P5_P2(R.X[u][1]) + C.mn2[1] * P5_P2(R.X[u + 2][1]);
        vm[u] = C.cm2[2] * P5_P2(R.X[u + 1][2]) + C.mp2[2] * P5_P2(R.X[u][2]) + C.mn2[2] * P5_P2(R.X[u + 2][2]);
        yv[u] = P5_P2(R.YF[u]) + P5_P2(R.YB[u]);
        const f32x2 asum = P5_P2(R.A0[u]) + P5_P2(R.A1[u]);
        const f32x2 ks = k_ * ((f32x2){2.0f, 2.0f} + (asum - (f32x2){2.0f, 2.0f}) * C.ka2);
        const f32x2 bt = r_ * ks * C.rk2;
        s1[u] = yv[u].x + yv[u].y; s3[u] = bt.x + bt.y;
    }
#pragma unroll
    for (int u = 0; u < 4; ++u) { s1[u] = row_sum<16>(s1[u]); s3[u] = row_sum<16>(s3[u]); }
#pragma unroll
    for (int u = 0; u < 4; ++u) { s1[u] += __shfl_xor(s1[u], 16); s3[u] += __shfl_xor(s3[u], 16); }
#pragma unroll
    for (int u = 0; u < 4; ++u) { const float mu = s1[u] * (1.0f / 64.0f); yv[u] = yv[u] - (f32x2){mu, mu}; s2[u] = row_sum<16>(yv[u].x * yv[u].x + yv[u].y * yv[u].y); }
#pragma unroll
    for (int u = 0; u < 4; ++u) s2[u] += __shfl_xor(s2[u], 16);
#pragma unroll
    for (int u = 0; u < 4; ++u) { const size_t m = (size_t)(m0 + u);
        const float rs = rsqrtf(s2[u] * (1.0f / 64.0f) + 64e-5f);
        const f32x2 o = (yv[u] * rs * C.lw2 + C.lb2 + vm[u] * s3[u]) * P5_P2(R.GW[u]);
        *(unsigned*)(C.cat + m * DM + 1024 + C.c0) = pk_bf(o.x, o.y);
        const float ra = rsqrtf(row_sum<16>(R.SS[u]) * (1.0f / 1024.0f) + 1e-6f);
        *(unsigned*)(C.cat + m * DM + 2 * C.tid) = pk_bf(bf_lo(R.AT[u]) * ra, bf_hi(R.AT[u]) * ra); }
}
#undef P5_P2
__device__ __forceinline__ void p5_post(const Args& a) {
    PostCtx C; C.tid = opaque_tid(); const int h = C.tid >> 5, cp = C.tid & 31; C.c0 = h * 64 + 2 * cp;
    C.rw = (const bf16_t*)(a.ws + WS_R1); C.ab = (const bf16_t*)((const unsigned char*)a.out + OUT_A); C.gb = (const bf16_t*)(a.ws + WS_G);
    C.yf = (const bf16_t*)((const unsigned char*)a.out + OUT_YF); C.yb = (const bf16_t*)((const unsigned char*)a.out + OUT_YB);
    C.cat = (bf16_t*)(a.ws + WS_R3); C.ssatt = (const float*)(a.ws + WS_SSATT);
#pragma unroll
    for (int q = 0; q < 3; ++q) { C.mp2[q] = *(const f32x2*)(a.in[6] + q * 1024 + C.c0); C.mn2[q] = *(const f32x2*)(a.in[7] + q * 1024 + C.c0); C.cm2[q] = (f32x2){1.0f, 1.0f} - C.mp2[q] - C.mn2[q]; }
    C.ka2 = *(const f32x2*)(a.in[14] + C.c0); C.rk2 = *(const f32x2*)(a.in[15] + C.c0); C.lw2 = *(const f32x2*)(a.in[16] + C.c0); C.lb2 = *(const f32x2*)(a.in[17] + C.c0);
    const int stride = gridDim.x * 4; int m0 = blockIdx.x * 4;
    PostRegs RA, RB;
    if (m0 < M_TOK) post_load(RA, C, m0);
    for (; m0 < M_TOK; m0 += 2 * stride) {
        const bool hb = m0 + stride < M_TOK;
        if (hb) post_load(RB, C, m0 + stride);
        post_compute(RA, C, m0);
        if (m0 + 2 * stride < M_TOK) post_load(RA, C, m0 + 2 * stride);
        if (hb) post_compute(RB, C, m0 + stride);
    }
}
__device__ __forceinline__ void p9_final(const Args& a) {
    const int tid = opaque_tid(), lane = tid & 63, wave = tid >> 6;
    const float* ss3 = (const float*)(a.ws + WS_SS3); const float* fg = a.in[23]; const bf16_t* xb = (const bf16_t*)(a.ws + WS_X1B);
    for (int row = blockIdx.x * 8 + wave; row < M_TOK; row += gridDim.x * 8) {
        const float rs = rsqrtf(ss3[row] * (1.0f / 2048.0f) + 1e-6f); float* o = a.out + (size_t)row * DM; const bf16_t* xi = xb + (size_t)row * DM;
        u32x4 w[4];
#pragma unroll
        for (int i = 0; i < 4; ++i) w[i] = *(const u32x4*)(xi + i * 512 + lane * 8);
#pragma unroll
        for (int i = 0; i < 4; ++i) { const int c = i * 512 + lane * 8; const f32x4 g0 = *(const f32x4*)(fg + c), g1 = *(const f32x4*)(fg + c + 4);
            const f32x4 x0 = (f32x4){bf_lo(w[i].x), bf_hi(w[i].x), bf_lo(w[i].y), bf_hi(w[i].y)}, x1 = (f32x4){bf_lo(w[i].z), bf_hi(w[i].z), bf_lo(w[i].w), bf_hi(w[i].w)};
            *(f32x4*)(o + c) = x0 * rs * g0; *(f32x4*)(o + c + 4) = x1 * rs * g1; }
    }
}

__global__ void __launch_bounds__(512, 2) fwd_mega(Args a) {
    extern __shared__ __attribute__((aligned(16))) unsigned char lds_raw[];
    LAS unsigned char* lds = (LAS unsigned char*)lds_raw;
    cg::grid_group grid = cg::this_grid();
    const int lo = a.ph_lo, hi = a.ph_hi, G = gridDim.x, bx = blockIdx.x;
    unsigned char* ws = a.ws;
#ifndef PH_MASK
#define PH_MASK 0x1fff
#endif
#define IN(k) (((PH_MASK >> (k)) & 1) && lo <= (k) && (k) < hi)
#define SEAM(k) do { if (IN(k) && IN((k) + 1)) grid.sync(); } while (0)
    if (IN(0)) { p0_prologue(a, lds); } SEAM(0);
    if (IN(1)) {
        pg8::Gemm g{(const bf16_t*)((const unsigned char*)a.out + OUT_XB), (const bf16_t*)(ws + WS_BT_IN), M_TOK, NPROJ, DM, DM, DM}; pg8::StaticOrder S; S.init(M_TOK, NPROJ, G, bx);
        pg8::EpiProj E{(bf16_t*)(ws + WS_R2), (bf16_t*)(ws + WS_R1), (const float*)(ws + WS_RSTD1)};
        pg8::gemm_phase<pg8::EpiProj, pg8::StaticOrder, true, true>(lds, g, S, E);
    } SEAM(1);
    if (IN(2)) { p2_lora_in(a); p2_na(a, lds); } SEAM(2);
    {
        const bf16_t* li = (const bf16_t*)(ws + WS_R3) + 1024;
        if (IN(3)) { pg8::Gemm g{li, (const bf16_t*)(ws + WS_BT_W), M_TOK, 2048, 128, DM, 128}; pg8::StaticOrder S; S.init(M_TOK, 2048, G, bx);
          pg8::EpiLora<0> E{(bf16_t*)(ws + WS_OMD), 2048, a.in[8]}; pg8::gemm_phase<pg8::EpiLora<0>, pg8::StaticOrder, true, true>(lds, g, S, E); }
        if (IN(4)) { pg8::Gemm g{li + 128, (const bf16_t*)(ws + WS_BT_A), M_TOK, 2048, 128, DM, 128}; pg8::StaticOrder S; S.init(M_TOK, 2048, G, bx);
          pg8::EpiLora<1> E{(bf16_t*)((unsigned char*)a.out + OUT_A), 2048, a.in[10]}; pg8::gemm_phase<pg8::EpiLora<1>, pg8::StaticOrder, true, true>(lds, g, S, E); }
        if (IN(5)) { pg8::Gemm g{li + 256, (const bf16_t*)(ws + WS_BT_G), M_TOK, 1024, 256, DM, 256}; pg8::StaticOrder S; S.init(M_TOK, 1024, G, bx);
          pg8::EpiLora<2> E{(bf16_t*)(ws + WS_G), 1024, nullptr}; pg8::gemm_phase<pg8::EpiLora<2>, pg8::StaticOrder, true, true>(lds, g, S, E); }
    } SEAM(5);
    if (IN(6)) { p4_scan(a, lds); } SEAM(6);
    if (IN(7)) { p6_corr(a, lds); } SEAM(7);
    if (IN(8)) { p5_post(a); } SEAM(8);
    if (IN(9)) {
        pg8::Gemm g{(const bf16_t*)(ws + WS_R3), (const bf16_t*)(ws + WS_BT_OUT), M_TOK, DM, DM, DM, DM}; pg8::StaticOrder S; S.init(M_TOK, DM, G, bx);
        pg8::EpiOut E{a.in[0], a.in[1], (bf16_t*)(ws + WS_X1B), (float*)(ws + WS_SS2)};
        pg8::gemm_phase<pg8::EpiOut, pg8::StaticOrder, true, true>(lds, g, S, E);
    } SEAM(9);
    if (IN(10)) {
        pg8::Gemm g{(const bf16_t*)(ws + WS_X1B), (const bf16_t*)(ws + WS_BT_GU), M_TOK, FF2, DM, DM, DM}; pg8::StaticOrder S; S.init(M_TOK, FF2, G, bx);
        pg8::EpiGU E{(bf16_t*)(ws + WS_H), (const float*)(ws + WS_SS2)};
        pg8::gemm_phase<pg8::EpiGU, pg8::StaticOrder, true, true>(lds, g, S, E);
    } SEAM(10);
    if (IN(11)) {
        pg8::Gemm g{(const bf16_t*)(ws + WS_H), (const bf16_t*)(ws + WS_BT_DOWN), M_TOK, DM, FF, FF, FF}; pg8::StaticOrder S; S.init(M_TOK, DM, G, bx);
        pg8::EpiDown E{(bf16_t*)(ws + WS_X1B), (float*)(ws + WS_SS3)};
        pg8::gemm_phase<pg8::EpiDown, pg8::StaticOrder, true, true>(lds, g, S, E);
    } SEAM(11);
    if (IN(12)) { p9_final(a); }
}

#ifndef MK_LAUNCHES
#define MK_LAUNCHES 1
#endif
extern "C" void kernel_launch(void* const* d_in, const int* in_sizes, int n_in, void* d_out, int out_size, void* d_ws, size_t ws_size, hipStream_t stream) {
    static int grid = 0;
    if (grid == 0) {
        if (n_in != 24 || out_size != M_TOK * DM || ws_size < WS_END) { fprintf(stderr, "kernel_launch: unexpected shapes: n_in %d out %d ws %zu (need %zu)\n", n_in, out_size, ws_size, (size_t)WS_END); grid = -1; return; }
        if (hipFuncSetAttribute((const void*)fwd_mega, hipFuncAttributeMaxDynamicSharedMemorySize, LDS_BYTES) != hipSuccess) { fprintf(stderr, "kernel_launch: hipFuncSetAttribute failed\n"); grid = -1; return; }
        int dev = 0, cus = 0, per_cu = 0;
        hipGetDevice(&dev); hipDeviceGetAttribute(&cus, hipDeviceAttributeMultiprocessorCount, dev);
        hipOccupancyMaxActiveBlocksPerMultiprocessor(&per_cu, (const void*)fwd_mega, 512, LDS_BYTES);
        (void)hipGetLastError();
        if (per_cu < 1) per_cu = 1;
        grid = cus;
        if (grid % 8 != 0) grid = (grid / 8) * 8;
    }
    if (grid < 0) return;
    Args a{};
    for (int i = 0; i < 24; ++i) a.in[i] = (const float*)d_in[i];
    a.out = (float*)d_out; a.ws = (unsigned char*)d_ws;
    if (MK_LAUNCHES == 1) {
        a.ph_lo = 0; a.ph_hi = NPH; void* args[] = {&a};
        hipError_t e = hipLaunchCooperativeKernel((const void*)fwd_mega, dim3(grid), dim3(512), args, LDS_BYTES, stream);
        if (e != hipSuccess) fprintf(stderr, "cooperative launch failed: %s (grid %d)\n", hipGetErrorString(e), grid);
    } else {
        for (int ph = 0; ph < NPH; ++ph) { a.ph_lo = ph; a.ph_hi = ph + 1; void* args[] = {&a};
            hipError_t e = hipLaunchCooperativeKernel((const void*)fwd_mega, dim3(grid), dim3(512), args, LDS_BYTES, stream);
            if (e != hipSuccess) { fprintf(stderr, "launch %d failed: %s (grid %d)\n", ph, hipGetErrorString(e), grid); break; } }
    }
}
```

```cpp
#include <hip/hip_runtime.h>
#include <hip/hip_cooperative_groups.h>
#include <cstdio>
#include <cstdint>
namespace cg = cooperative_groups;
namespace pg8 {
#define PG8_LAS __attribute__((address_space(3)))
typedef unsigned short bf16_t;
typedef short bf16x8 __attribute__((ext_vector_type(8)));
typedef float f32x4 __attribute__((ext_vector_type(4)));
typedef unsigned u32x4 __attribute__((ext_vector_type(4)));
constexpr int BM = 256, BK = 64, HALF = 128, HTB = HALF * BK * 2  , STAGE_BYTES = 8 * HTB, NXCD = 8, WGM = 8;

__host__ __device__ __forceinline__ int lds_byte(int r, int c) { const int st = (r >> 4) * 2 + (c >> 5), rr = r & 15, cc = c & 31, ob = rr * 64 + cc * 2; return st * 1024 + (ob ^ (((ob >> 9) & 1) << 5)); }
__host__ __device__ __forceinline__ void stage_rc(int b, int& R, int& C) { const int st = b / 1024, sb = b % 1024, swz = sb ^ (((sb >> 9) & 1) << 5); R = (st >> 1) * 16 + swz / 64; C = (st & 1) * 32 + (swz % 64) / 2; }
__host__ __device__ __forceinline__ int perm32(int rho) { const int n = rho >> 4, i = rho & 15; return 8 * (i >> 2) + 4 * n + (i & 3); }

struct Unit { int pm, pn; };
struct Gemm { const bf16_t* A; const bf16_t* Bt; int M, N, K, lda, ldb; };

struct StaticOrder {
    int nM, nN, nwg, G, c;
    __host__ __device__ void init(int M, int N, int G_, int c_) { nM = M / BM; nN = N / BM; nwg = nM * nN; G = G_; c = c_; }
    __host__ __device__ bool next(int i, Unit& u) const {
        const long L = (long)i * G + c; if (L >= nwg) return false;
        int wgid = (int)L; { const int q = nwg / NXCD, r = nwg % NXCD, xcd = wgid % NXCD, off = wgid / NXCD; wgid = (xcd < r ? xcd * (q + 1) : r * (q + 1) + (xcd - r) * q) + off; }
        const int nig = WGM * nN, gid = wgid / nig, fm = gid * WGM, gsz = (nM - fm) < WGM ? (nM - fm) : WGM;
        u.pm = fm + ((wgid % nig) % gsz); u.pn = (wgid % nig) / gsz; return true;
    }
    __device__ __forceinline__ void a_ready(const Unit&) const {}
    __device__ __forceinline__ void done(const Unit&) const {}
};
__device__ __forceinline__ unsigned cvt_pk_bf16(float lo, float hi) { unsigned r; asm volatile("v_cvt_pk_bf16_f32 %0, %1, %2" : "=v"(r) : "v"(lo), "v"(hi)); return r; }
__device__ __forceinline__ u32x4 pack8(const f32x4 v0, const f32x4 v1) { u32x4 w; w.x = cvt_pk_bf16(v0[0], v0[1]); w.y = cvt_pk_bf16(v0[2], v0[3]); w.z = cvt_pk_bf16(v1[0], v1[1]); w.w = cvt_pk_bf16(v1[2], v1[3]); return w; }
__device__ __forceinline__ float sigmoidf_(float x) { return 1.0f / (1.0f + __expf(-x)); }

struct EpiProj {
    static constexpr bool PERM = true, AFTER_DRAIN = false;
    bf16_t* att; bf16_t* rw; const float* rstd;
    __device__ __forceinline__ void operator()(const f32x4 (&acc)[2][2][4][2], const Unit& u, int wr, int wc, int fr, int fq) const {
        const int colt = u.pn * BM; bf16_t* base; int ld, c0;
        if (colt < 3072) { base = att; ld = 3072; c0 = colt; } else { base = rw; ld = 3584; c0 = colt - 3072; }
        c0 += wc * 32 + 8 * fq;
#pragma unroll
        for (int ai = 0; ai < 2; ++ai)
#pragma unroll
            for (int m = 0; m < 4; ++m) { const int row = u.pm * BM + ai * HALF + wr * 64 + m * 16 + fr; const float s = rstd[row]; bf16_t* rowp = base + (size_t)row * ld + c0;
#pragma unroll
                for (int bj = 0; bj < 2; ++bj) *(u32x4*)(rowp + bj * HALF) = pack8(acc[ai][bj][m][0] * s, acc[ai][bj][m][1] * s); }
    }
};
template <int MODE> struct EpiLora {
    static constexpr bool PERM = true, AFTER_DRAIN = false;
    bf16_t* O; int ldc; const float* bias;
    __device__ __forceinline__ float f(float v) const {
        if (MODE == 0) return 1.0f - __expf(-0.60653066f * sigmoidf_(v));
        if (MODE == 1) return sigmoidf_(v);
        return v;
    }
    __device__ __forceinline__ void operator()(const f32x4 (&acc)[2][2][4][2], const Unit& u, int wr, int wc, int fr, int fq) const {
        const int col0 = u.pn * BM + wc * 32 + 8 * fq;
#pragma unroll
        for (int bj = 0; bj < 2; ++bj) {
            const f32x4 b0 = (MODE != 2) ? *(const f32x4*)(bias + col0 + bj * HALF) : (f32x4){0.f, 0.f, 0.f, 0.f}, b1 = (MODE != 2) ? *(const f32x4*)(bias + col0 + bj * HALF + 4) : (f32x4){0.f, 0.f, 0.f, 0.f};
#pragma unroll
            for (int ai = 0; ai < 2; ++ai)
#pragma unroll
                for (int m = 0; m < 4; ++m) { const int row = u.pm * BM + ai * HALF + wr * 64 + m * 16 + fr; bf16_t* rowp = O + (size_t)row * ldc + col0;
                    f32x4 v0 = acc[ai][bj][m][0] + b0, v1 = acc[ai][bj][m][1] + b1;
#pragma unroll
                    for (int j = 0; j < 4; ++j) { v0[j] = f(v0[j]); v1[j] = f(v1[j]); }
                    *(u32x4*)(rowp + bj * HALF) = pack8(v0, v1); }
        }
    }
};
struct EpiOut {
    static constexpr bool PERM = true, AFTER_DRAIN = false;
    const float* xp; const float* xs; bf16_t* xb; float* ss;
    __device__ __forceinline__ void operator()(const f32x4 (&acc)[2][2][4][2], const Unit& u, int wr, int wc, int fr, int fq) const {
        const int col0 = u.pn * BM + wc * 32 + 8 * fq;
#pragma unroll
        for (int ai = 0; ai < 2; ++ai)
#pragma unroll
            for (int m = 0; m < 4; ++m) { const int row = u.pm * BM + ai * HALF + wr * 64 + m * 16 + fr;
                const float* xin = (row < 32768 ? xp + (size_t)row * 2048 : xs + (size_t)(row - 32768) * 2048) + col0;
                bf16_t* bp = xb + (size_t)row * 2048 + col0; float sq = 0.f;
#pragma unroll
                for (int bj = 0; bj < 2; ++bj) { const f32x4 x0 = *(const f32x4*)(xin + bj * HALF) + acc[ai][bj][m][0], x1 = *(const f32x4*)(xin + bj * HALF + 4) + acc[ai][bj][m][1];
                    *(u32x4*)(bp + bj * HALF) = pack8(x0, x1);
                    sq += (x0[0] * x0[0] + x0[1] * x0[1]) + (x0[2] * x0[2] + x0[3] * x0[3]) + (x1[0] * x1[0] + x1[1] * x1[1]) + (x1[2] * x1[2] + x1[3] * x1[3]); }
                sq += __shfl_xor(sq, 16); sq += __shfl_xor(sq, 32);
                if (fq == 0) atomicAdd(ss + row, sq); }
    }
};
struct EpiGU {
    static constexpr bool PERM = true, AFTER_DRAIN = false;
    bf16_t* H; const float* ss;
    __device__ __forceinline__ void operator()(const f32x4 (&acc)[2][2][4][2], const Unit& u, int wr, int wc, int fr, int fq) const {
        const int col0 = u.pn * HALF + wc * 32 + 8 * fq;
#pragma unroll
        for (int ai = 0; ai < 2; ++ai)
#pragma unroll
            for (int m = 0; m < 4; ++m) { const int row = u.pm * BM + ai * HALF + wr * 64 + m * 16 + fr; const float rs = rsqrtf(ss[row] * (1.0f / 2048.0f) + 1e-6f);
                f32x4 h[2];
#pragma unroll
                for (int n = 0; n < 2; ++n)
#pragma unroll
                    for (int j = 0; j < 4; ++j) { const float g = acc[ai][0][m][n][j] * rs, uu = acc[ai][1][m][n][j] * rs; h[n][j] = g * uu * sigmoidf_(g); }
                *(u32x4*)(H + (size_t)row * 5632 + col0) = pack8(h[0], h[1]); }
    }
};
struct EpiDown {
    static constexpr bool PERM = true, AFTER_DRAIN = false;
    bf16_t* xb; float* ss;
    __device__ __forceinline__ void operator()(const f32x4 (&acc)[2][2][4][2], const Unit& u, int wr, int wc, int fr, int fq) const {
        const int col0 = u.pn * BM + wc * 32 + 8 * fq;
#pragma unroll
        for (int ai = 0; ai < 2; ++ai)
#pragma unroll
            for (int m = 0; m < 4; ++m) { const int row = u.pm * BM + ai * HALF + wr * 64 + m * 16 + fr; bf16_t* bp = xb + (size_t)row * 2048 + col0; float sq = 0.f;
#pragma unroll
                for (int bj = 0; bj < 2; ++bj) { const u32x4 w = *(const u32x4*)(bp + bj * HALF);
                    const f32x4 x0 = (f32x4){__uint_as_float(w.x << 16), __uint_as_float(w.x & 0xffff0000u), __uint_as_float(w.y << 16), __uint_as_float(w.y & 0xffff0000u)} + acc[ai][bj][m][0];
                    const f32x4 x1 = (f32x4){__uint_as_float(w.z << 16), __uint_as_float(w.z & 0xffff0000u), __uint_as_float(w.w << 16), __uint_as_float(w.w & 0xffff0000u)} + acc[ai][bj][m][1];
                    *(u32x4*)(bp + bj * HALF) = pack8(x0, x1);
                    sq += (x0[0] * x0[0] + x0[1] * x0[1]) + (x0[2] * x0[2] + x0[3] * x0[3]) + (x1[0] * x1[0] + x1[1] * x1[1]) + (x1[2] * x1[2] + x1[3] * x1[3]); }
                sq += __shfl_xor(sq, 16); sq += __shfl_xor(sq, 32);
                if (fq == 0) atomicAdd(ss + row, sq); }
    }
};
template <class Epi, class Sched, bool ALIGN_EPI = false, bool SP2 = false>
__device__ __forceinline__ void gemm_phase(PG8_LAS unsigned char* lds, const Gemm g, const Sched& S, const Epi& E) {
    int tid_ = threadIdx.x; asm volatile("" : "+v"(tid_));
    const int tid = tid_, wid = __builtin_amdgcn_readfirstlane(tid >> 6), lane = tid & 63, wr = wid >> 2, wc = wid & 3, fr = lane & 15, fq = lane >> 4;
    const int K = g.K, nt = K / BK;
    unsigned voffA[2], voffB[2];
#pragma unroll
    for (int i = 0; i < 2; ++i) { int R, C; stage_rc(tid * 16 + i * 8192, R, C); const int Rb = Epi::PERM ? ((R & ~31) + perm32(R & 31)) : R;
        voffA[i] = (unsigned)(R * g.lda + C) * 2u; voffB[i] = (unsigned)(Rb * g.ldb + C) * 2u; }
    const size_t kstep = (size_t)(BK * 2);
    const size_t hstepA = (size_t)HALF * g.lda * 2, hstepB = (size_t)HALF * g.ldb * 2;
    const size_t tstepA = 2 * hstepA, tstepB = 2 * hstepB;
    const unsigned ldsw = (unsigned)wid * 1024u;
    const int aoff = lds_byte(wr * 64 + fr, fq * 8), boff = lds_byte(wc * 32 + fr, fq * 8);
#define PG8_SA(b, h) (((b) * 2 + (h)) * HTB)
#define PG8_SB(b, h) ((4 + (b) * 2 + (h)) * HTB)
#define PG8_STAGE(bufoff, gbase, voff) do { _Pragma("unroll") for (int _i = 0; _i < 2; ++_i) \
        __builtin_amdgcn_global_load_lds((const unsigned*)((const char*)(gbase) + (voff)[_i]), (PG8_LAS unsigned*)(lds + (bufoff) + ldsw + _i * 8192), 16, 0, 0); } while (0)
#define PG8_LDA(dst, b, h) do { _Pragma("unroll") for (int m = 0; m < 4; ++m) _Pragma("unroll") for (int k = 0; k < 2; ++k) dst[m][k] = *(const PG8_LAS bf16x8*)(lds + PG8_SA(b, h) + aoff + m * 2048 + k * 1024); } while (0)
#define PG8_LDB(dst, b, h) do { _Pragma("unroll") for (int n = 0; n < 2; ++n) _Pragma("unroll") for (int k = 0; k < 2; ++k) dst[n][k] = *(const PG8_LAS bf16x8*)(lds + PG8_SB(b, h) + boff + n * 2048 + k * 1024); } while (0)
#define PG8_MMA(ai, bj, At, Bt) do { __builtin_amdgcn_s_setprio(1); _Pragma("unroll") for (int m = 0; m < 4; ++m) _Pragma("unroll") for (int n = 0; n < 2; ++n) _Pragma("unroll") for (int k = 0; k < 2; ++k) \
        acc[ai][bj][m][n] = __builtin_amdgcn_mfma_f32_16x16x32_bf16(Bt[n][k], At[m][k], acc[ai][bj][m][n], 0, 0, 0); __builtin_amdgcn_s_setprio(0); } while (0)
#define PG8_WAIT_V(n) asm volatile("s_waitcnt vmcnt(" #n ")" ::: "memory")
#define PG8_WAIT_L(n) asm volatile("s_waitcnt lgkmcnt(" #n ")" ::: "memory")
#define PG8_BAR __builtin_amdgcn_s_barrier()
#define PG8_SCHED __builtin_amdgcn_sched_barrier(0)
    Unit cur, nxt; int ui = 0;
    if (!S.next(0, cur)) return;
    f32x4 acc[2][2][4][2];
#pragma unroll
    for (int a = 0; a < 2; ++a)
#pragma unroll
        for (int b = 0; b < 2; ++b)
#pragma unroll
            for (int m = 0; m < 4; ++m)
#pragma unroll
                for (int n = 0; n < 2; ++n) acc[a][b][m][n] = (f32x4){0.f, 0.f, 0.f, 0.f};
    bf16x8 At[4][2], B0[2][2], B1[2][2];
    const char* cA = (const char*)g.A + (size_t)cur.pm * tstepA; const char* cB = (const char*)g.Bt + (size_t)cur.pn * tstepB;
    S.a_ready(cur);
    if constexpr (SP2) {
        PG8_STAGE(PG8_SB(0, 0), cB, voffB); PG8_STAGE(PG8_SB(0, 1), cB + hstepB, voffB); PG8_STAGE(PG8_SA(0, 0), cA, voffA); PG8_STAGE(PG8_SA(0, 1), cA + hstepA, voffA);
        if (wr == 1) PG8_BAR;
        PG8_WAIT_V(2); PG8_BAR;
        PG8_STAGE(PG8_SB(1, 0), cB + kstep, voffB); PG8_STAGE(PG8_SA(1, 0), cA + kstep, voffA); PG8_STAGE(PG8_SB(1, 1), cB + hstepB + kstep, voffB);
        PG8_WAIT_V(6); PG8_BAR;
    } else {
        PG8_STAGE(PG8_SB(0, 0), cB, voffB); PG8_STAGE(PG8_SA(0, 0), cA, voffA); PG8_STAGE(PG8_SB(0, 1), cB + hstepB, voffB); PG8_STAGE(PG8_SA(0, 1), cA + hstepA, voffA);
        if (wr == 1) PG8_BAR;
        PG8_WAIT_V(4); PG8_BAR;
        PG8_STAGE(PG8_SB(1, 0), cB + kstep, voffB); PG8_STAGE(PG8_SA(1, 0), cA + kstep, voffA); PG8_STAGE(PG8_SB(1, 1), cB + hstepB + kstep, voffB);
        PG8_WAIT_V(6); PG8_BAR;
    }
    for (;;) {
        const bool has_next = S.next(ui + 1, nxt);
        const char* nA = has_next ? (const char*)g.A + (size_t)nxt.pm * tstepA : cA; const char* nB = has_next ? (const char*)g.Bt + (size_t)nxt.pn * tstepB : cB;
        for (int t = 0; t < nt; t += 2) {
            const bool last = (t == nt - 2);
            const char* a1 = cA + (size_t)(t + 1) * kstep;
            const char* a2 = last ? nA : cA + (size_t)(t + 2) * kstep; const char* b2 = last ? nB : cB + (size_t)(t + 2) * kstep;
            const char* a3 = a2 + kstep; const char* b3 = b2 + kstep;
            if (last && has_next) S.a_ready(nxt);
            if constexpr (SP2) {
            PG8_LDB(B0, 0, 0); PG8_LDB(B1, 0, 1); PG8_SCHED; PG8_LDA(At, 0, 0); PG8_STAGE(PG8_SA(1, 1), a1 + hstepA, voffA);
            PG8_WAIT_V(8); PG8_WAIT_L(0); PG8_BAR; PG8_MMA(0, 0, At, B0); PG8_MMA(0, 1, At, B1); PG8_BAR; PG8_SCHED;
            PG8_LDA(At, 0, 1); PG8_STAGE(PG8_SB(0, 0), b2, voffB); PG8_STAGE(PG8_SB(0, 1), b2 + hstepB, voffB); PG8_STAGE(PG8_SA(0, 0), a2, voffA);
            PG8_WAIT_V(8); PG8_WAIT_L(0); PG8_BAR; PG8_MMA(1, 0, At, B0); PG8_MMA(1, 1, At, B1); PG8_BAR; PG8_SCHED;
            PG8_LDB(B0, 1, 0); PG8_LDB(B1, 1, 1); PG8_SCHED; PG8_LDA(At, 1, 0); PG8_STAGE(PG8_SA(0, 1), a2 + hstepA, voffA);
            PG8_WAIT_V(8); PG8_WAIT_L(0); PG8_BAR; PG8_MMA(0, 0, At, B0); PG8_MMA(0, 1, At, B1); PG8_BAR; PG8_SCHED;
            PG8_LDA(At, 1, 1); PG8_STAGE(PG8_SB(1, 0), b3, voffB); PG8_STAGE(PG8_SB(1, 1), b3 + hstepB, voffB); PG8_STAGE(PG8_SA(1, 0), a3, voffA);
            PG8_WAIT_V(8); PG8_WAIT_L(0); PG8_BAR; PG8_MMA(1, 0, At, B0); PG8_MMA(1, 1, At, B1); PG8_BAR; PG8_SCHED;
            } else {
            PG8_LDB(B0, 0, 0); PG8_SCHED; PG8_LDA(At, 0, 0); PG8_STAGE(PG8_SA(1, 1), a1 + hstepA, voffA);
            PG8_WAIT_L(8); PG8_BAR; PG8_WAIT_L(0); PG8_MMA(0, 0, At, B0); PG8_BAR; PG8_SCHED;
            PG8_LDB(B1, 0, 1); PG8_STAGE(PG8_SB(0, 0), b2, voffB);
            PG8_BAR; PG8_WAIT_L(0); PG8_MMA(0, 1, At, B1); PG8_BAR;
            PG8_LDA(At, 0, 1); PG8_STAGE(PG8_SA(0, 0), a2, voffA);
            PG8_BAR; PG8_WAIT_L(0); PG8_MMA(1, 0, At, B0); PG8_BAR; PG8_SCHED;
            PG8_STAGE(PG8_SB(0, 1), b2 + hstepB, voffB);
            PG8_WAIT_V(6); PG8_BAR; PG8_MMA(1, 1, At, B1); PG8_BAR;
            PG8_LDB(B0, 1, 0); PG8_SCHED; PG8_LDA(At, 1, 0); PG8_STAGE(PG8_SA(0, 1), a2 + hstepA, voffA);
            PG8_WAIT_L(8); PG8_BAR; PG8_WAIT_L(0); PG8_MMA(0, 0, At, B0); PG8_BAR; PG8_SCHED;
            PG8_LDB(B1, 1, 1); PG8_STAGE(PG8_SB(1, 0), b3, voffB);
            PG8_BAR; PG8_WAIT_L(0); PG8_MMA(0, 1, At, B1); PG8_BAR;
            PG8_LDA(At, 1, 1); PG8_STAGE(PG8_SA(1, 0), a3, voffA);
            PG8_BAR; PG8_WAIT_L(0); PG8_MMA(1, 0, At, B0); PG8_BAR; PG8_SCHED;
            PG8_STAGE(PG8_SB(1, 1), b3 + hstepB, voffB);
            PG8_WAIT_V(6); PG8_BAR; PG8_MMA(1, 1, At, B1); PG8_BAR;
            }
        }
        if constexpr (ALIGN_EPI) { if (wr == 0) PG8_BAR; }
        if constexpr (!Epi::AFTER_DRAIN) { E(acc, cur, wr, wc, fr, fq); S.done(cur); }
        if (!has_next) break;
#pragma unroll
        for (int a = 0; a < 2; ++a)
#pragma unroll
            for (int b = 0; b < 2; ++b)
#pragma unroll
                for (int m = 0; m < 4; ++m)
#pragma unroll
                    for (int n = 0; n < 2; ++n) acc[a][b][m][n] = (f32x4){0.f, 0.f, 0.f, 0.f};
        cur = nxt; cA = nA; cB = nB; ++ui;
        if constexpr (ALIGN_EPI) { if (wr == 1) PG8_BAR; }
    }
    PG8_WAIT_V(0);
    if constexpr (!ALIGN_EPI) { if (wr == 0) PG8_BAR; }
    PG8_BAR;
    if constexpr (Epi::AFTER_DRAIN) { E.fused(acc, cur, wr, wc, fr, fq, lds, wid, lane); S.done(cur); }
#undef PG8_SA
#undef PG8_SB
#undef PG8_STAGE
#undef PG8_LDA
#undef PG8_LDB
#undef PG8_MMA
#undef PG8_WAIT_V
#undef PG8_WAIT_L
#undef PG8_BAR
#undef PG8_SCHED
}
}

#define LAS __attribute__((address_space(3)))
typedef unsigned short bf16_t;
typedef short bf16x8 __attribute__((ext_vector_type(8)));
typedef float f32x4 __attribute__((ext_vector_type(4)));
typedef float f32x2 __attribute__((ext_vector_type(2)));
typedef unsigned u32x4 __attribute__((ext_vector_type(4)));
typedef unsigned u32x2 __attribute__((ext_vector_type(2)));

constexpr int M_TOK = 49152, M_PROMPT = 32768, DM = 2048, NPROJ = 6656, NATT = 3072, NRW = 3584, FF = 5632, FF2 = 11264;
constexpr size_t MiB = (size_t)1 << 20;
constexpr size_t WS_BT_IN = 0, WS_BT_OUT = 26 * MiB, WS_BT_GU = 34 * MiB, WS_BT_DOWN = 78 * MiB, WS_BT_W = 100 * MiB, WS_BT_A = 100 * MiB + 512 * 1024, WS_BT_G = 101 * MiB,
                 WS_RSTD1 = 102 * MiB, WS_SS2 = 102 * MiB + 256 * 1024, WS_SS3 = 102 * MiB + 512 * 1024, WS_SSATT = 103 * MiB,
                 WS_R1 = 112 * MiB  , WS_R2 = 448 * MiB  , WS_R3 = 736 * MiB  ,
                 WS_OMD = WS_R2, WS_G = WS_R2 + 192 * MiB, WS_X1B = WS_R1, WS_H = 304 * MiB, WS_SA = 107 * MiB  , WS_BAR = 108 * MiB  , WS_QB = 928 * MiB  , WS_END = 992 * MiB;
constexpr size_t OUT_XB = 0, OUT_YF = 0, OUT_YB = 96 * MiB, OUT_A = 192 * MiB;
constexpr int LDS_BYTES = 136 * 1024;
constexpr int NPH = 13;

__device__ __forceinline__ int opaque_tid() { int t = threadIdx.x; asm volatile("" : "+v"(t)); return t; }
struct Args { const float* in[24]; float* out; unsigned char* ws; int ph_lo, ph_hi; };

__device__ __forceinline__ float bf_lo(unsigned w) { return __uint_as_float(w << 16); }
__device__ __forceinline__ float bf_hi(unsigned w) { return __uint_as_float(w & 0xffff0000u); }
__device__ __forceinline__ unsigned pk_bf(float lo, float hi) { return pg8::cvt_pk_bf16(lo, hi); }
__device__ __forceinline__ float wave_sum(float v) { v += __shfl_xor(v, 1); v += __shfl_xor(v, 2); v += __shfl_xor(v, 4); v += __shfl_xor(v, 8); v += __shfl_xor(v, 16); v += __shfl_xor(v, 32); return v; }
__device__ __forceinline__ float half_sum(float v) { v += __shfl_xor(v, 1); v += __shfl_xor(v, 2); v += __shfl_xor(v, 4); v += __shfl_xor(v, 8); v += __shfl_xor(v, 16); return v; }
template <int CTRL> __device__ __forceinline__ float dpp_add(float x) { const int v = __builtin_amdgcn_update_dpp(0, __float_as_int(x), CTRL, 0xF, 0xF, false); return x + __int_as_float(v); }
template <int LPR> __device__ __forceinline__ float row_sum(float x) {
    x = dpp_add<0xB1>(x); x = dpp_add<0x4E>(x); x = dpp_add<0x141>(x); if (LPR == 16) x = dpp_add<0x140>(x); return x;
}

__device__ __forceinline__ void tr_tile(LAS float* tile, const float* src, int ldsrc, int nvalid, const float* sc, int sc_n, bf16_t* dst, int lddst, int k0, int n0, int drow0, int tid) {
    const int kk = tid >> 4, n4 = (tid & 15) * 4;
#pragma unroll
    for (int p = 0; p < 2; ++p) { const int k = kk + 32 * p, n = n0 + n4; f32x4 v = (f32x4){0.f, 0.f, 0.f, 0.f};
        if (n < nvalid) v = *(const f32x4*)(src + (size_t)(k0 + k) * ldsrc + n);
        const float s = (sc != nullptr && (k0 + k) < sc_n) ? sc[k0 + k] : 1.0f;
        tile[k * 65 + n4 + 0] = v[0] * s; tile[k * 65 + n4 + 1] = v[1] * s; tile[k * 65 + n4 + 2] = v[2] * s; tile[k * 65 + n4 + 3] = v[3] * s; }
    __syncthreads();
    const int nn = tid >> 3, kc = (tid & 7) * 8; float e[8];
#pragma unroll
    for (int j = 0; j < 8; ++j) e[j] = tile[(kc + j) * 65 + nn];
    u32x4 w; w.x = pk_bf(e[0], e[1]); w.y = pk_bf(e[2], e[3]); w.z = pk_bf(e[4], e[5]); w.w = pk_bf(e[6], e[7]);
    *(u32x4*)(dst + (size_t)(drow0 + nn) * lddst + k0 + kc) = w;
    __syncthreads();
}

__device__ __forceinline__ void late_weights(const Args& a, LAS unsigned char* lds, int vb, int nvb) {
    const int tid = opaque_tid(); unsigned char* ws = a.ws; LAS float* tile = (LAS float*)lds;
    bf16_t* Bt_out = (bf16_t*)(ws + WS_BT_OUT); bf16_t* Bt_gu = (bf16_t*)(ws + WS_BT_GU); bf16_t* Bt_down = (bf16_t*)(ws + WS_BT_DOWN);
    for (int job = 3328 + vb; job < 12800; job += nvb) {
        const float* src; const float* sc; bf16_t* dst; int ldsrc, scn, lddst, k0, n0, d0;
        if (job < 4352) { const int j = job - 3328, kt = j / 32, nt = j % 32; src = a.in[18]; ldsrc = 2048; sc = a.in[5]; scn = 1024; dst = Bt_out; lddst = 2048; k0 = kt * 64; n0 = nt * 64; d0 = n0; }
        else if (job < 9984) { const int up = job >= 7168, j = job - (up ? 7168 : 4352), kt = j / 88, nt = j % 88; src = up ? a.in[21] : a.in[20]; ldsrc = 5632; sc = a.in[19]; scn = 2048; dst = Bt_gu; lddst = 2048; k0 = kt * 64; n0 = nt * 64; d0 = (n0 / 128) * 256 + (up ? 128 : 0) + (n0 % 128); }
        else { const int j = job - 9984, kt = j / 32, nt = j % 32; src = a.in[22]; ldsrc = 2048; sc = nullptr; scn = 0; dst = Bt_down; lddst = 5632; k0 = kt * 64; n0 = nt * 64; d0 = n0; }
        tr_tile(tile, src, ldsrc, ldsrc, sc, scn, dst, lddst, k0, n0, d0, tid);
    }
}
__device__ __forceinline__ void p0_prologue(const Args& a, LAS unsigned char* lds) {
    const int tid = opaque_tid(), lane = tid & 63, wave = tid >> 6, G = gridDim.x, bx = blockIdx.x;
    unsigned char* ws = a.ws;
    LAS float* tile = (LAS float*)lds;
    bf16_t* Bt_in = (bf16_t*)(ws + WS_BT_IN); bf16_t* Bt_out = (bf16_t*)(ws + WS_BT_OUT); bf16_t* Bt_gu = (bf16_t*)(ws + WS_BT_GU); bf16_t* Bt_down = (bf16_t*)(ws + WS_BT_DOWN);
    for (int job = bx; job < 12800; job += G) {
        if (job < 3328) { const int kt = job / 104, nt = job % 104; tr_tile(tile, a.in[3], 6560, 6560, a.in[2], 2048, Bt_in, 2048, kt * 64, nt * 64, nt * 64, tid); }
        else if (job < 4352) { const int j = job - 3328, kt = j / 32, nt = j % 32; tr_tile(tile, a.in[18], 2048, 2048, a.in[5], 1024, Bt_out, 2048, kt * 64, nt * 64, nt * 64, tid); }
        else if (job < 7168) { const int j = job - 4352, kt = j / 88, nt = j % 88, n0 = nt * 64; tr_tile(tile, a.in[20], 5632, 5632, a.in[19], 2048, Bt_gu, 2048, kt * 64, n0, (n0 / 128) * 256 + (n0 % 128), tid); }
        else if (job < 9984) { const int j = job - 7168, kt = j / 88, nt = j % 88, n0 = nt * 64; tr_tile(tile, a.in[21], 5632, 5632, a.in[19], 2048, Bt_gu, 2048, kt * 64, n0, (n0 / 128) * 256 + 128 + (n0 % 128), tid); }
        else { const int j = job - 9984, kt = j / 32, nt = j % 32; tr_tile(tile, a.in[22], 2048, 2048, nullptr, 0, Bt_down, 5632, kt * 64, nt * 64, nt * 64, tid); }
    }
    bf16_t* Bt_w = (bf16_t*)(ws + WS_BT_W); bf16_t* Bt_a = (bf16_t*)(ws + WS_BT_A); bf16_t* Bt_g = (bf16_t*)(ws + WS_BT_G);
    float* ss2 = (float*)(ws + WS_SS2); float* ss3 = (float*)(ws + WS_SS3);
    const float* w2 = a.in[9]; const float* a2 = a.in[11]; const float* g2 = a.in[12];
    for (int idx = bx * 512 + tid; idx < 2048 * 128; idx += G * 512) { const int n = idx >> 7, k = idx & 127, e = n >> 10, c = n & 1023, e2 = k >> 6, l = k & 63;
        const float wv = (e == e2) ? w2[(size_t)(e * 64 + l) * 1024 + c] : 0.f, av = (e == e2) ? a2[(size_t)(e * 64 + l) * 1024 + c] : 0.f;
        Bt_w[idx] = (bf16_t)(pk_bf(wv, 0.f) & 0xffffu); Bt_a[idx] = (bf16_t)(pk_bf(av, 0.f) & 0xffffu); }
    for (int idx = bx * 512 + tid; idx < 1024 * 256; idx += G * 512) { const int n = idx >> 8, k = idx & 255; const float gv = (k < 160) ? g2[(size_t)k * 1024 + n] : 0.f; Bt_g[idx] = (bf16_t)(pk_bf(gv, 0.f) & 0xffffu); }
    for (int idx = bx * 512 + tid; idx < M_TOK; idx += G * 512) { ss2[idx] = 0.f; ss3[idx] = 0.f; }
    bf16_t* xb = (bf16_t*)((unsigned char*)a.out + OUT_XB); float* rstd1 = (float*)(ws + WS_RSTD1);
    for (int row = bx * 8 + wave; row < M_TOK; row += G * 8) {
        const float* xr = row < M_PROMPT ? a.in[0] + (size_t)row * DM : a.in[1] + (size_t)(row - M_PROMPT) * DM;
        f32x4 v[8]; float ss = 0.f;
#pragma unroll
        for (int i = 0; i < 8; ++i) { v[i] = *(const f32x4*)(xr + i * 256 + lane * 4); ss += (v[i][0] * v[i][0] + v[i][1] * v[i][1]) + (v[i][2] * v[i][2] + v[i][3] * v[i][3]); }
        ss = wave_sum(ss);
        if (lane == 0) rstd1[row] = rsqrtf(ss * (1.0f / 2048.0f) + 1e-6f);
#pragma unroll
        for (int i = 0; i < 8; ++i) { u32x2 w; w.x = pk_bf(v[i][0], v[i][1]); w.y = pk_bf(v[i][2], v[i][3]); *(u32x2*)(xb + (size_t)row * DM + i * 256 + lane * 4) = w; }
    }
}

__device__ __forceinline__ void p2_lora_in(const Args& a) {
    const bf16_t* rw = (const bf16_t*)(a.ws + WS_R1); bf16_t* cat = (bf16_t*)(a.ws + WS_R3);
    const float* mup = a.in[6]; const float* mun = a.in[7];
    for (int idx = blockIdx.x * 512 + opaque_tid(); idx < M_TOK * 256; idx += gridDim.x * 512) {
        const int row = idx >> 8, c = (idx & 255) * 2; unsigned outw = 0u;
        if (c < 416) {
            const int sc = 3072 + c; const int t = row < M_PROMPT ? (row & 8191) : row - M_PROMPT, T = row < M_PROMPT ? 8192 : 16384;
            const unsigned pc = *(const unsigned*)(rw + (size_t)row * NRW + sc);
            const unsigned pp = t > 0 ? *(const unsigned*)(rw + (size_t)(row - 1) * NRW + sc) : 0u;
            const unsigned pn = t < T - 1 ? *(const unsigned*)(rw + (size_t)(row + 1) * NRW + sc) : 0u;
            float u0 = bf_lo(pc), u1 = bf_hi(pc);
            u0 = u0 + mup[sc] * (bf_lo(pp) - u0) + mun[sc] * (bf_lo(pn) - u0);
            u1 = u1 + mup[sc + 1] * (bf_hi(pp) - u1) + mun[sc + 1] * (bf_hi(pn) - u1);
            if (c < 128) { u0 = tanhf(u0); u1 = tanhf(u1); } else if (c >= 256) { u0 = pg8::sigmoidf_(u0); u1 = pg8::sigmoidf_(u1); }
            outw = pk_bf(u0, u1);
        }
        *(unsigned*)(cat + (size_t)row * DM + 1024 + c) = outw;
    }
}
__device__ __forceinline__ void p2_na(const Args& a, LAS unsigned char* lds) {
    const int tid = opaque_tid(), lane = tid & 63, wave = __builtin_amdgcn_readfirstlane(tid >> 6), l16 = lane & 15, g = lane >> 4;
    const bf16_t* pa = (const bf16_t*)(a.ws + WS_R2); bf16_t* cat = (bf16_t*)(a.ws + WS_R3); float* ssatt = (float*)(a.ws + WS_SSATT);
    const float* rpb = a.in[4];
    LAS unsigned* Vt = (LAS unsigned*)lds;
    LAS float* BL = (LAS float*)(lds + 128 * 260 * 4);
    const int hh = wave >> 2, cw = wave & 3, cb = cw == 0 ? 0 : (cw == 1 ? 8 : (cw == 2 ? 24 : 32));
    const int c = 16 * cw + l16; int cs = c - 8; cs = cs < 0 ? 0 : (cs > 48 ? 48 : cs);
    float madd[2][4]; const LAS float* bp[2][4];
#pragma unroll
    for (int hf = 0; hf < 2; ++hf)
#pragma unroll
        for (int ii = 0; ii < 4; ++ii) { const int kc = cb + 16 * hf + 4 * g + ii; madd[hf][ii] = ((kc >= cs) && (kc < cs + 16)) ? 0.f : -1e30f; bp[hf][ii] = BL + 32 + hh * 248 + (kc - c + 15); }
    const int koff = (cb + l16) * NATT + 8 * g, qoff = (16 * cw + l16) * NATT + 8 * g;
    const LAS unsigned* pA[4]; const LAS unsigned* pB[4];
#pragma unroll
    for (int dt = 0; dt < 4; ++dt) { const int d = 16 * dt + l16, sw = 4 * ((d >> 3) & 7), cc = (cb >> 1) + 2 * g; pA[dt] = Vt + (hh * 64 + d) * 260 + (cc ^ sw); pB[dt] = Vt + (hh * 64 + d) * 260 + ((cc + 8) ^ sw); }
    for (int unit = blockIdx.x; unit < 6144; unit += gridDim.x) {
        const int hp = unit & 7, sr = unit >> 3;
        int r, rows, base_tok;
        if (sr < 512) { r = sr & 127; rows = 128; base_tok = (sr >> 7) * 8192; } else { r = sr - 512; rows = 256; base_tok = M_PROMPT; }
        int r0 = r - 4; r0 = r0 < 0 ? 0 : (r0 > rows - 8 ? rows - 8 : r0);
        const int t0 = base_tok + r0 * 64, tq = base_tok + r * 64;
        bf16x8 q0, q1, kf[16][2];
        {
            const int vh = tid >> 8, q = tid & 255, j = q & 7, pl = q >> 3;
            const bf16_t* vsrc = pa + (size_t)t0 * NATT + 2048 + (2 * hp + vh) * 64 + 8 * j;
            u32x4 x[8], y[8];
#pragma unroll
            for (int it = 0; it < 8; ++it) { const int pi = it * 32 + pl; x[it] = *(const u32x4*)(vsrc + (size_t)(2 * pi) * NATT); y[it] = *(const u32x4*)(vsrc + (size_t)(2 * pi + 1) * NATT); }
            {
                const bf16_t* qb = pa + (size_t)tq * NATT + (2 * hp + hh) * 64; const bf16_t* kb = pa + (size_t)t0 * NATT + 1024 + (2 * hp + hh) * 64;
                q0 = *(const bf16x8*)(qb + qoff); q1 = *(const bf16x8*)(qb + qoff + 32);
#pragma unroll
                for (int kt = 0; kt < 16; ++kt) { const bf16_t* kp = kb + (size_t)(64 * (kt >> 1) + 16 * (kt & 1)) * NATT + koff; kf[kt][0] = *(const bf16x8*)kp; kf[kt][1] = *(const bf16x8*)(kp + 32); }
            }
            __builtin_amdgcn_sched_barrier(0);
            if (tid < 496) { const int bh = tid / 248, rem = tid % 248, bi = rem / 31, dc = rem % 31; BL[32 + tid] = rpb[((2 * hp + bh) * 15 + (r0 + bi - r + 7)) * 31 + dc] * 1.44269504f; }
            else if (tid < 560) { const int z = tid - 496; BL[z < 32 ? z : 496 + z] = 0.f; }
#pragma unroll
            for (int it = 0; it < 8; ++it) { const int col = (it * 32 + pl) ^ (4 * j);
#pragma unroll
                for (int e = 0; e < 4; ++e) { Vt[(vh * 64 + 8 * j + 2 * e) * 260 + col] = (x[it][e] & 0xffffu) | (y[it][e] << 16); Vt[(vh * 64 + 8 * j + 2 * e + 1) * 260 + col] = (x[it][e] >> 16) | (y[it][e] & 0xffff0000u); } }
        }
        __syncthreads();
        {
            const int h = 2 * hp + hh;
            f32x4 s[16];
#pragma unroll
            for (int kt = 0; kt < 16; ++kt) { f32x4 acc = (f32x4){0.f, 0.f, 0.f, 0.f};
                acc = __builtin_amdgcn_mfma_f32_16x16x32_bf16(kf[kt][0], q0, acc, 0, 0, 0);
                acc = __builtin_amdgcn_mfma_f32_16x16x32_bf16(kf[kt][1], q1, acc, 0, 0, 0);
                s[kt] = acc; }
            float mx = -1e30f;
#pragma unroll
            for (int kt = 0; kt < 16; ++kt) { const int i = kt >> 1, hf = kt & 1;
#pragma unroll
                for (int ii = 0; ii < 4; ++ii) { const float v = s[kt][ii] * (0.125f * 1.44269504f) + (bp[hf][ii][i * 31] + madd[hf][ii]); s[kt][ii] = v; mx = fmaxf(mx, v); } }
            mx = fmaxf(mx, __shfl_xor(mx, 16)); mx = fmaxf(mx, __shfl_xor(mx, 32));
            float sum = 0.f;
#pragma unroll
            for (int kt = 0; kt < 16; ++kt)
#pragma unroll
                for (int ii = 0; ii < 4; ++ii) { const float p = __builtin_amdgcn_exp2f(s[kt][ii] - mx); s[kt][ii] = p; sum += p; }
            sum += __shfl_xor(sum, 16); sum += __shfl_xor(sum, 32);
            f32x4 o[4];
#pragma unroll
            for (int dt = 0; dt < 4; ++dt) o[dt] = (f32x4){0.f, 0.f, 0.f, 0.f};
#pragma unroll
            for (int i = 0; i < 8; ++i) {
                u32x4 pw; pw.x = pk_bf(s[2 * i][0], s[2 * i][1]); pw.y = pk_bf(s[2 * i][2], s[2 * i][3]); pw.z = pk_bf(s[2 * i + 1][0], s[2 * i + 1][1]); pw.w = pk_bf(s[2 * i + 1][2], s[2 * i + 1][3]);
                const bf16x8 pf = __builtin_bit_cast(bf16x8, pw);
#pragma unroll
                for (int dt = 0; dt < 4; ++dt) {
                    const u32x2 va = *(const LAS u32x2*)(pA[dt] + 32 * i), vb = *(const LAS u32x2*)(pB[dt] + 32 * i);
                    u32x4 vw; vw.x = va.x; vw.y = va.y; vw.z = vb.x; vw.w = vb.y;
                    o[dt] = __builtin_amdgcn_mfma_f32_16x16x32_bf16(__builtin_bit_cast(bf16x8, vw), pf, o[dt], 0, 0, 0); }
            }
            const float inv = 1.0f / sum; float sq = 0.f;
            bf16_t* op = cat + (size_t)(tq + 16 * cw + l16) * DM + h * 64 + 4 * g;
#pragma unroll
            for (int dt = 0; dt < 4; ++dt) { const f32x4 v = o[dt] * inv; sq += (v[0] * v[0] + v[1] * v[1]) + (v[2] * v[2] + v[3] * v[3]);
                u32x2 w; w.x = pk_bf(v[0], v[1]); w.y = pk_bf(v[2], v[3]); *(u32x2*)(op + 16 * dt) = w; }
            sq += __shfl_xor(sq, 16); sq += __shfl_xor(sq, 32);
            if (g == 0) ssatt[(size_t)(tq + 16 * cw + l16) * 16 + h] = sq;
        }
        __syncthreads();
    }
}
constexpr int SC_TC = 16;
template <int LPR, int RPL> __device__ __forceinline__ void scan_chain(const Args& a, LAS unsigned char* lds, int e, int tok_base, int T, int h, int rowbase, int s0, int nsteps, int mode) {
    constexpr int NE = 64 / LPR, NP = NE / 2, GPW = 64 / LPR, RPW = RPL * GPW, NROW = 4 * RPW, YST = NROW * LPR;
    const int tid = opaque_tid(), lane = tid & 63, wave = tid >> 6;
    LAS float* buf = (LAS float*)lds;
    LAS float* ypart = (LAS float*)(lds + 2 * SC_TC * 6 * 64 * 4);
    const int NC = nsteps / SC_TC;
    if (wave >= 4) {
        const int lt = tid - 256, ts0 = lt >> 5, cp = lt & 31, c0 = h * 64 + 2 * cp;
        const bf16_t* rw = (const bf16_t*)(a.ws + WS_R1); const bf16_t* omd = (const bf16_t*)(a.ws + WS_OMD); const bf16_t* ab = (const bf16_t*)((const unsigned char*)a.out + OUT_A);
        bf16_t* Y = (bf16_t*)((unsigned char*)a.out + (e ? OUT_YB : OUT_YF)); float* Qb = (float*)(a.ws + WS_QB) + (size_t)e * 8192 * 1024;
        f32x2 mp2[3], mn2[3], cm2[3];
#pragma unroll
        for (int q = 0; q < 3; ++q) { mp2[q] = *(const f32x2*)(a.in[6] + q * 1024 + c0); mn2[q] = *(const f32x2*)(a.in[7] + q * 1024 + c0); cm2[q] = (f32x2){1.0f, 1.0f} - mp2[q] - mn2[q]; }
        const f32x2 kkc2 = *(const f32x2*)(a.in[13] + c0), ka2 = *(const f32x2*)(a.in[14] + c0), omka2 = (f32x2){1.0f, 1.0f} - ka2;
        unsigned R[2][11];
        const bool yrow = (2 * cp >= rowbase) && (2 * cp < rowbase + NROW);
#define SC_LOAD(chunk) do { _Pragma("unroll") for (int sl = 0; sl < 2; ++sl) { const int s_ = s0 + (chunk) * SC_TC + 2 * ts0 + sl; const int t_ = e ? (T - 1 - s_) : s_; const size_t tok_ = (size_t)(tok_base + t_); \
        const bf16_t* p_ = rw + tok_ * NRW + c0; \
        _Pragma("unroll") for (int q = 0; q < 3; ++q) { R[sl][3 * q + 1] = *(const unsigned*)(p_ + q * 1024); \
            R[sl][3 * q + 0] = t_ > 0 ? *(const unsigned*)(p_ - NRW + q * 1024) : 0u; R[sl][3 * q + 2] = t_ < T - 1 ? *(const unsigned*)(p_ + NRW + q * 1024) : 0u; } \
        R[sl][9] = *(const unsigned*)(omd + tok_ * 2048 + e * 1024 + c0); R[sl][10] = *(const unsigned*)(ab + tok_ * 2048 + e * 1024 + c0); } } while (0)
#define SC_P2(x) ((f32x2){bf_lo(x), bf_hi(x)})
#define SC_MIX2(sl, q) (cm2[q] * SC_P2(R[sl][3 * (q) + 1]) + mp2[q] * SC_P2(R[sl][3 * (q)]) + mn2[q] * SC_P2(R[sl][3 * (q) + 2]))
#define SC_STORE(nb) do { f32x2 r_[2], k_[2], v_[2], kk_[2], a_[2], w_[2]; \
        _Pragma("unroll") for (int sl = 0; sl < 2; ++sl) { r_[sl] = SC_MIX2(sl, 0); k_[sl] = SC_MIX2(sl, 1); v_[sl] = SC_MIX2(sl, 2); \
            const f32x2 q_ = k_[sl] * kkc2; float n2_ = row_sum<16>(q_.x * q_.x + q_.y * q_.y); n2_ += __shfl_xor(n2_, 16); const float in_ = rsqrtf(fmaxf(n2_, 1e-24f)); \
            kk_[sl] = q_ * in_; a_[sl] = SC_P2(R[sl][10]); w_[sl] = (f32x2){1.0f, 1.0f} - SC_P2(R[sl][9]); } \
          \
        const f32x2 p2_ = w_[0] * w_[1]; f32x2 po_; po_.x = __shfl_xor(p2_.x, 32); po_.y = __shfl_xor(p2_.y, 32); \
        const f32x2 base_ = (lane & 32) ? po_ : (f32x2){1.0f, 1.0f}; \
        f32x2 gp_[2], g_[2]; gp_[0] = base_; g_[0] = base_ * w_[0]; gp_[1] = g_[0]; g_[1] = g_[0] * w_[1]; \
        _Pragma("unroll") for (int sl = 0; sl < 2; ++sl) { LAS float* b_ = buf + ((nb) * SC_TC + 2 * ts0 + sl) * 6 * 64 + 2 * cp; \
            const f32x2 ig_ = (f32x2){__builtin_amdgcn_rcpf(g_[sl].x), __builtin_amdgcn_rcpf(g_[sl].y)}; \
            *(LAS f32x2*)(b_ + 0 * 64) = -(kk_[sl] * gp_[sl]); \
            *(LAS f32x2*)(b_ + 1 * 64) = g_[sl]; \
            *(LAS f32x2*)(b_ + 2 * 64) = k_[sl] * (omka2 + a_[sl] * ka2) * ig_; \
            *(LAS f32x2*)(b_ + 3 * 64) = kk_[sl] * a_[sl] * ig_; \
            *(LAS f32x2*)(b_ + 4 * 64) = r_[sl] * g_[sl]; \
            *(LAS f32x2*)(b_ + 5 * 64) = (mode == 1) ? (f32x2){0.f, 0.f} : v_[sl]; } } while (0)
#define SC_YOUT(chunk) do { if (yrow) { _Pragma("unroll") for (int sl = 0; sl < 2; ++sl) { const int sr_ = (chunk) * SC_TC + 2 * ts0 + sl, s_ = s0 + sr_; const int t_ = e ? (T - 1 - s_) : s_; \
        const LAS float* y_ = ypart + (((chunk) & 1) * SC_TC + 2 * ts0 + sl) * YST + (2 * cp - rowbase) * LPR; float ya_ = 0.f, yb_ = 0.f; \
        _Pragma("unroll") for (int j = 0; j < LPR; j += 4) { const f32x4 u_ = *(const LAS f32x4*)(y_ + j), w_ = *(const LAS f32x4*)(y_ + LPR + j); ya_ += (u_[0] + u_[1]) + (u_[2] + u_[3]); yb_ += (w_[0] + w_[1]) + (w_[2] + w_[3]); } \
        if (mode == 1) *(f32x2*)(Qb + (size_t)sr_ * 1024 + c0) = (f32x2){ya_, yb_}; \
        else *(unsigned*)(Y + (size_t)(tok_base + t_) * 1024 + c0) = pk_bf(ya_, yb_); } } } while (0)
        SC_LOAD(0); SC_STORE(0);
        __syncthreads();
        for (int c = 0; c < NC; ++c) {
            if (c + 1 < NC) SC_LOAD(c + 1);
            if (c > 0) SC_YOUT(c - 1);
            if (c + 1 < NC) SC_STORE((c + 1) & 1);
            __syncthreads();
        }
        SC_YOUT(NC - 1);
#undef SC_LOAD
#undef SC_P2
#undef SC_MIX2
#undef SC_STORE
#undef SC_YOUT
    } else {
        const int part = lane % LPR, rloc = lane / LPR;
        f32x2 S[RPL][NP];
#pragma unroll
        for (int rr = 0; rr < RPL; ++rr)
#pragma unroll
            for (int p = 0; p < NP; ++p) { const int row_ = rowbase + wave * RPW + rr * GPW + rloc, col_ = part * NE + 2 * p; S[rr][p] = (f32x2){(mode == 1 && col_ == row_) ? 1.f : 0.f, (mode == 1 && col_ + 1 == row_) ? 1.f : 0.f}; }
        __syncthreads();
        for (int c = 0; c < NC; ++c) {
            const LAS float* bc = buf + (c & 1) * SC_TC * 384 + part * NE;
            const LAS float* vc = buf + (c & 1) * SC_TC * 384 + 320 + rowbase + wave * RPW + rloc;
            LAS float* yp = ypart + (c & 1) * SC_TC * YST + wave * (RPL * 64) + lane;
            f32x4 nx[5][NE / 4]; float nv[RPL];
#pragma unroll
            for (int q = 0; q < 5; ++q)
#pragma unroll
                for (int j = 0; j < NE / 4; ++j) nx[q][j] = *(const LAS f32x4*)(bc + q * 64 + 4 * j);
#pragma unroll
            for (int rr = 0; rr < RPL; ++rr) nv[rr] = vc[rr * GPW];
#pragma unroll
            for (int st = 0; st < SC_TC; ++st) {
                f32x2 z[NP], w[NP], kd[NP], bq[NP], rv[NP]; float vv[RPL];
#pragma unroll
                for (int j = 0; j < NE / 4; ++j) { z[2 * j] = (f32x2){nx[0][j][0], nx[0][j][1]}; z[2 * j + 1] = (f32x2){nx[0][j][2], nx[0][j][3]}; w[2 * j] = (f32x2){nx[1][j][0], nx[1][j][1]}; w[2 * j + 1] = (f32x2){nx[1][j][2], nx[1][j][3]};
                    kd[2 * j] = (f32x2){nx[2][j][0], nx[2][j][1]}; kd[2 * j + 1] = (f32x2){nx[2][j][2], nx[2][j][3]}; bq[2 * j] = (f32x2){nx[3][j][0], nx[3][j][1]}; bq[2 * j + 1] = (f32x2){nx[3][j][2], nx[3][j][3]};
                    rv[2 * j] = (f32x2){nx[4][j][0], nx[4][j][1]}; rv[2 * j + 1] = (f32x2){nx[4][j][2], nx[4][j][3]}; }
#pragma unroll
                for (int rr = 0; rr < RPL; ++rr) vv[rr] = nv[rr];
                if (st + 1 < SC_TC) {
#pragma unroll
                    for (int q = 0; q < 5; ++q)
#pragma unroll
                        for (int j = 0; j < NE / 4; ++j) if (q != 1 || ((st + 1) & 3) == 3) nx[q][j] = *(const LAS f32x4*)(bc + (st + 1) * 384 + q * 64 + 4 * j);
#pragma unroll
                    for (int rr = 0; rr < RPL; ++rr) nv[rr] = vc[(st + 1) * 384 + rr * GPW];
                }
#pragma unroll
                for (int rr = 0; rr < RPL; ++rr) {
                    f32x2 acc = S[rr][0] * z[0];
#pragma unroll
                    for (int p = 1; p < NP; ++p) acc = S[rr][p] * z[p] + acc;
                    const float sz = row_sum<LPR>(acc.x + acc.y);
                    const f32x2 sz2 = (f32x2){sz, sz}, v2 = (f32x2){vv[rr], vv[rr]};
                    f32x2 ya = (f32x2){0.f, 0.f};
#pragma unroll
                    for (int p = 0; p < NP; ++p) { const f32x2 t = v2 * kd[p] + S[rr][p]; S[rr][p] = sz2 * bq[p] + t; ya = S[rr][p] * rv[p] + ya; }
                    yp[st * YST + rr * 64] = ya.x + ya.y;
                    if ((st & 3) == 3) {
#pragma unroll
                        for (int p = 0; p < NP; ++p) S[rr][p] = S[rr][p] * w[p]; }
                }
            }
            __syncthreads();
        }
        if (mode == 2) { float* SA = (float*)(a.ws + WS_SA) + (size_t)(e * 16 + h) * 4096;
#pragma unroll
            for (int rr = 0; rr < RPL; ++rr)
#pragma unroll
                for (int p = 0; p < NP; ++p) *(f32x2*)(SA + (rowbase + wave * RPW + rr * GPW + rloc) * 64 + part * NE + 2 * p) = S[rr][p]; }
    }
    __syncthreads();
}
__device__ __forceinline__ void p4_scan(const Args& a, LAS unsigned char* lds) {
    for (int task = blockIdx.x; task < 224; task += gridDim.x) {
        int e, h, tok_base, T, s0, mode;
        if (task < 128) { const int b = task >> 5; h = (task >> 1) & 15; e = task & 1; tok_base = b * 8192; T = 8192; s0 = 0; mode = 0; }
        else { const int j = task - 128, kind = j >> 5, eh = j & 31; e = eh & 1; h = eh >> 1; tok_base = M_PROMPT; T = 16384; s0 = kind == 0 ? 0 : 8192; mode = kind == 0 ? 2 : (kind == 1 ? 0 : 1); }
        scan_chain<8, 2>(a, lds, e, tok_base, T, h, 0, s0, 8192, mode);
    }
}
__device__ __forceinline__ void p6_corr(const Args& a, LAS unsigned char* lds) {
    const int tid = opaque_tid(), lane = tid & 63, wave = __builtin_amdgcn_readfirstlane(tid >> 6);
    LAS float* qt = (LAS float*)lds;
    for (int unit = blockIdx.x; unit < 256; unit += gridDim.x) {
        const int eh = unit >> 3, chunk = unit & 7, e = eh & 1, h = eh >> 1;
        const float* sa = (const float*)(a.ws + WS_SA) + ((size_t)(e * 16 + h) * 64 + lane) * 64;
        f32x4 sv[16];
#pragma unroll
        for (int j = 0; j < 16; ++j) sv[j] = *(const f32x4*)(sa + 4 * j);
        bf16_t* Y = (bf16_t*)((unsigned char*)a.out + (e ? OUT_YB : OUT_YF));
        const float* qb = (const float*)(a.ws + WS_QB) + (size_t)e * 8192 * 1024 + h * 64;
        for (int sub = 0; sub < 8; ++sub) {
            const int sbase = chunk * 1024 + sub * 128;
            f32x4 ql[4];
#pragma unroll
            for (int k = 0; k < 4; ++k) { const int idx = tid + 512 * k; ql[k] = *(const f32x4*)(qb + (size_t)(sbase + (idx >> 4)) * 1024 + (idx & 15) * 4); }
            unsigned short yv[16];
#pragma unroll
            for (int k = 0; k < 16; ++k) { const int sidx = sbase + wave * 16 + k; const int t = e ? (16384 - 1 - (8192 + sidx)) : (8192 + sidx); yv[k] = Y[(size_t)(M_PROMPT + t) * 1024 + h * 64 + lane]; }
#pragma unroll
            for (int k = 0; k < 4; ++k) { const int idx = tid + 512 * k; *(LAS f32x4*)(qt + (idx >> 4) * 64 + (idx & 15) * 4) = ql[k]; }
            __syncthreads();
#pragma unroll 4
            for (int k = 0; k < 16; ++k) { const int sidx = sbase + wave * 16 + k; const int t = e ? (16384 - 1 - (8192 + sidx)) : (8192 + sidx);
                const LAS float* q = qt + (wave * 16 + k) * 64; f32x4 acc = (f32x4){0.f, 0.f, 0.f, 0.f};
#pragma unroll
                for (int j = 0; j < 16; ++j) acc += sv[j] * *(const LAS f32x4*)(q + 4 * j);
                const float y = __uint_as_float((unsigned)yv[k] << 16) + ((acc[0] + acc[1]) + (acc[2] + acc[3]));
                Y[(size_t)(M_PROMPT + t) * 1024 + h * 64 + lane] = (bf16_t)(pk_bf(y, 0.f) & 0xffffu); }
            __syncthreads();
        }
    }
}
struct PostRegs { unsigned X[6][3], A0[4], A1[4], GW[4], YF[4], YB[4], AT[4]; float SS[4]; };
struct PostCtx { const bf16_t* rw; const bf16_t* ab; const bf16_t* gb; const bf16_t* yf; const bf16_t* yb; bf16_t* cat; const float* ssatt; int tid, c0; f32x2 mp2[3], mn2[3], cm2[3], ka2, rk2, lw2, lb2; };
__device__ __forceinline__ void post_load(PostRegs& R, const PostCtx& C, int m0) {
    const int t0 = m0 < M_PROMPT ? (m0 & 8191) : m0 - M_PROMPT, T = m0 < M_PROMPT ? 8192 : 16384;
#pragma unroll
    for (int j = 0; j < 6; ++j) { const int t = t0 - 1 + j; const bool ok = (t >= 0) && (t < T); const bf16_t* p = C.rw + (size_t)(m0 - 1 + j) * NRW + C.c0;
#pragma unroll
        for (int q = 0; q < 3; ++q) R.X[j][q] = ok ? *(const unsigned*)(p + q * 1024) : 0u; }
#pragma unroll
    for (int u = 0; u < 4; ++u) { const size_t m = (size_t)(m0 + u);
        R.A0[u] = *(const unsigned*)(C.ab + m * 2048 + C.c0); R.A1[u] = *(const unsigned*)(C.ab + m * 2048 + 1024 + C.c0); R.GW[u] = *(const unsigned*)(C.gb + m * 1024 + C.c0);
        R.YF[u] = *(const unsigned*)(C.yf + m * 1024 + C.c0); R.YB[u] = *(const unsigned*)(C.yb + m * 1024 + C.c0); R.AT[u] = *(const unsigned*)(C.cat + m * DM + 2 * C.tid);
        R.SS[u] = C.ssatt[m * 16 + (C.tid & 15)]; }
}
#define P5_P2(x) ((f32x2){bf_lo(x), bf_hi(x)})
__device__ __forceinline__ void post_compute(const PostRegs& R, const PostCtx& C, int m0) {
    float s1[4], s2[4], s3[4]; f32x2 yv[4], vm[4];
#pragma unroll
    for (int u = 0; u < 4; ++u) {
        const f32x2 r_ = C.cm2[0] * P5_P2(R.X[u + 1][0]) + C.mp2[0] * P5_P2(R.X[u][0]) + C.mn2[0] * P5_P2(R.X[u + 2][0]);
        const f32x2 k_ = C.cm2[1] * P5_P2(R.X[u + 1][1]) + C.mp2[1] * P5_P2(R.X[u][1]) + C.mn2[1] * P5_P2(R.X[u + 2][1]);
        vm[u] = C.cm2[2] * P5_P2(R.X[u + 1][2]) + C.mp2[2] * P5_P2(R.X[u][2]) + C.mn2[2] * P5_P2(R.X[u + 2][2]);
        yv[u] = P5_P2(R.YF[u]) + P5_P2(R.YB[u]);
        const f32x2 asum = P5_P2(R.A0[u]) + P5_P2(R.A1[u]);
        const f32x2 ks = k_ * ((f32x2){2.0f, 2.0f} + (asum - (f32x2){2.0f, 2.0f}) * C.ka2);
        const f32x2 bt = r_ * ks * C.rk2;
        s1[u] = yv[u].x + yv[u].y; s3[u] = bt.x + bt.y;
    }
#pragma unroll
    for (int u = 0; u < 4; ++u) { s1[u] = row_sum<16>(s1[u]); s3[u] = row_sum<16>(s3[u]); }
#pragma unroll
    for (int u = 0; u < 4; ++u) { s1[u] += __shfl_xor(s1[u], 16); s3[u] += __shfl_xor(s3[u], 16); }
#pragma unroll
    for (int u = 0; u < 4; ++u) { const float mu = s1[u] * (1.0f / 64.0f); yv[u] = yv[u] - (f32x2){mu, mu}; s2[u] = row_sum<16>(yv[u].x * yv[u].x + yv[u].y * yv[u].y); }
#pragma unroll
    for (int u = 0; u < 4; ++u) s2[u] += __shfl_xor(s2[u], 16);
#pragma unroll
    for (int u = 0; u < 4; ++u) { const size_t m = (size_t)(m0 + u);
        const float rs = rsqrtf(s2[u] * (1.0f / 64.0f) + 64e-5f);
        const f32x2 o = (yv[u] * rs * C.lw2 + C.lb2 + vm[u] * s3[u]) * P5_P2(R.GW[u]);
        *(unsigned*)(C.cat + m * DM + 1024 + C.c0) = pk_bf(o.x, o.y);
        const float ra = rsqrtf(row_sum<16>(R.SS[u]) * (1.0f / 1024.0f) + 1e-6f);
        *(unsigned*)(C.cat + m * DM + 2 * C.tid) = pk_bf(bf_lo(R.AT[u]) * ra, bf_hi(R.AT[u]) * ra); }
}
#undef P5_P2
__device__ __forceinline__ void p5_post(const Args& a) {
    PostCtx C; C.tid = opaque_tid(); const int h = C.tid >> 5, cp = C.tid & 31; C.c0 = h * 64 + 2 * cp;
    C.rw = (const bf16_t*)(a.ws + WS_R1); C.ab = (const bf16_t*)((const unsigned char*)a.out + OUT_A); C.gb = (const bf16_t*)(a.ws + WS_G);
    C.yf = (const bf16_t*)((const unsigned char*)a.out + OUT_YF); C.yb = (const bf16_t*)((const unsigned char*)a.out + OUT_YB);
    C.cat = (bf16_t*)(a.ws + WS_R3); C.ssatt = (const float*)(a.ws + WS_SSATT);
#pragma unroll
    for (int q = 0; q < 3; ++q) { C.mp2[q] = *(const f32x2*)(a.in[6] + q * 1024 + C.c0); C.mn2[q] = *(const f32x2*)(a.in[7] + q * 1024 + C.c0); C.cm2[q] = (f32x2){1.0f, 1.0f} - C.mp2[q] - C.mn2[q]; }
    C.ka2 = *(const f32x2*)(a.in[14] + C.c0); C.rk2 = *(const f32x2*)(a.in[15] + C.c0); C.lw2 = *(const f32x2*)(a.in[16] + C.c0); C.lb2 = *(const f32x2*)(a.in[17] + C.c0);
    const int stride = gridDim.x * 4; int m0 = blockIdx.x * 4;
    PostRegs RA, RB;
    if (m0 < M_TOK) post_load(RA, C, m0);
    for (; m0 < M_TOK; m0 += 2 * stride) {
        const bool hb = m0 + stride < M_TOK;
        if (hb) post_load(RB, C, m0 + stride);
        post_compute(RA, C, m0);
        if (m0 + 2 * stride < M_TOK) post_load(RA, C, m0 + 2 * stride);
        if (hb) post_compute(RB, C, m0 + stride);
    }
}
__device__ __forceinline__ void p9_final(const Args& a) {
    const int tid = opaque_tid(), lane = tid & 63, wave = tid >> 6;
    const float* ss3 = (const float*)(a.ws + WS_SS3); const float* fg = a.in[23]; const bf16_t* xb = (const bf16_t*)(a.ws + WS_X1B);
    for (int row = blockIdx.x * 8 + wave; row < M_TOK; row += gridDim.x * 8) {
        const float rs = rsqrtf(ss3[row] * (1.0f / 2048.0f) + 1e-6f); float* o = a.out + (size_t)row * DM; const bf16_t* xi = xb + (size_t)row * DM;
        u32x4 w[4];
#pragma unroll
        for (int i = 0; i < 4; ++i) w[i] = *(const u32x4*)(xi + i * 512 + lane * 8);
#pragma unroll
        for (int i = 0; i < 4; ++i) { const int c = i * 512 + lane * 8; const f32x4 g0 = *(const f32x4*)(fg + c), g1 = *(const f32x4*)(fg + c + 4);
            const f32x4 x0 = (f32x4){bf_lo(w[i].x), bf_hi(w[i].x), bf_lo(w[i].y), bf_hi(w[i].y)}, x1 = (f32x4){bf_lo(w[i].z), bf_hi(w[i].z), bf_lo(w[i].w), bf_hi(w[i].w)};
            *(f32x4*)(o + c) = x0 * rs * g0; *(f32x4*)(o + c + 4) = x1 * rs * g1; }
    }
}

#define XB_TMO      128
#define XB_XCNT(j)  (256  + 64 * (j))
#define XB_XSUB(j)  (1280 + 64 * (j))
#define XB_XGEN(j)  (2304 + 64 * (j))
#define XB_TOP      3328
#define XB_TOPGEN   3392
#define XCD_BAR_WORDS 3456
#define XB_SPIN_CAP (1u << 18)

__device__ __forceinline__ unsigned xb_ld(unsigned* p)              { return __hip_atomic_load(p, __ATOMIC_RELAXED, __HIP_MEMORY_SCOPE_AGENT); }
__device__ __forceinline__ unsigned xb_add(unsigned* p, unsigned v) { return __hip_atomic_fetch_add(p, v, __ATOMIC_RELAXED, __HIP_MEMORY_SCOPE_AGENT); }
__device__ __forceinline__ unsigned xb_xcc_id() { return (unsigned)__builtin_amdgcn_s_getreg((3 << 11) | 20) & 0xFu; }
#define XB_SPIN(cond, bar) do { unsigned _sp = 0; while (cond) { __builtin_amdgcn_s_sleep(1); \
    if ((++_sp & 255u) == 0u) { if (xb_ld(&(bar)[XB_TMO])) break; if (_sp > XB_SPIN_CAP) { atomicAdd(&(bar)[XB_TMO], 1u); break; } } } } while (0)

struct XcdBarrier {
    unsigned* bar; unsigned x;
    volatile LAS unsigned* st;
};

__device__ __forceinline__ XcdBarrier xcd_barrier_post(unsigned* bar, volatile LAS unsigned* st) {
    XcdBarrier b; b.bar = bar; b.x = xb_xcc_id(); b.st = st;
    if (threadIdx.x == 0) (void)xb_add(&bar[XB_XCNT(b.x)], 1u);
    return b;
}
__device__ __forceinline__ void xcd_barrier_complete(unsigned* bar, unsigned x, unsigned& nloc, unsigned& nx) {
    const unsigned G = gridDim.x * gridDim.y * gridDim.z;
    unsigned sum, cnt, mine, sp = 0u;
    for (;;) {
        sum = 0u; cnt = 0u; mine = 0u;
#pragma unroll
        for (unsigned j = 0; j < 16; ++j) { const unsigned c = xb_ld(&bar[XB_XCNT(j)]); sum += c; cnt += (c > 0u) ? 1u : 0u; mine = (j == x) ? c : mine; }
        if (sum == G) break;
        __builtin_amdgcn_s_sleep(1);
        if ((++sp & 255u) == 0u) { if (xb_ld(&bar[XB_TMO])) break; if (sp > XB_SPIN_CAP) { atomicAdd(&bar[XB_TMO], 1u); break; } }
    }
    nloc = mine > 0u ? mine : 1u; nx = cnt > 0u ? cnt : 1u;
}

__device__ __forceinline__ void xcd_barrier(const XcdBarrier& b) {
    asm volatile("s_waitcnt vmcnt(0)" ::: "memory");
    __syncthreads();
    if (threadIdx.x == 0) {
        unsigned* bar = b.bar;
        __builtin_amdgcn_s_waitcnt(0);
        unsigned nloc = b.st[0], nx = b.st[1];
        if (nloc == 0u) { xcd_barrier_complete(bar, b.x, nloc, nx); b.st[0] = nloc; b.st[1] = nx; }
        const unsigned old = xb_add(&bar[XB_XSUB(b.x)], 1u);
        const unsigned gen = old / nloc;
        if (old + 1u == (gen + 1u) * nloc) {
            __builtin_amdgcn_fence(__ATOMIC_RELEASE, "agent");
            asm volatile("s_waitcnt vmcnt(0)" ::: "memory");
            const unsigned og = xb_add(&bar[XB_TOP], 1u);
            const unsigned tg = og / nx;
            if (og + 1u == (tg + 1u) * nx) xb_add(&bar[XB_TOPGEN], 1u);
            else XB_SPIN(xb_ld(&bar[XB_TOPGEN]) == tg, bar);
            __builtin_amdgcn_fence(__ATOMIC_ACQUIRE, "agent");
            xb_add(&bar[XB_XGEN(b.x)], 1u);
            asm volatile("s_waitcnt vmcnt(0)" ::: "memory");
        } else {
            XB_SPIN(xb_ld(&bar[XB_XGEN(b.x)]) == gen, bar);
            __builtin_amdgcn_fence(__ATOMIC_ACQUIRE, "agent");
            asm volatile("s_waitcnt vmcnt(0)" ::: "memory");
        }
    }
    __syncthreads();
}
__global__ void __launch_bounds__(512, 2) fwd_mega(Args a) {
    extern __shared__ __attribute__((aligned(16))) unsigned char lds_raw[];
    LAS unsigned char* lds = (LAS unsigned char*)lds_raw;
    cg::grid_group grid = cg::this_grid();
    const int lo = a.ph_lo, hi = a.ph_hi, G = gridDim.x, bx = blockIdx.x;
    unsigned char* ws = a.ws;
    volatile LAS unsigned* xst = (volatile LAS unsigned*)(lds + LDS_BYTES - 16);
    if (threadIdx.x == 0) { xst[0] = 0u; xst[1] = 0u; }
    __syncthreads();
    const XcdBarrier xbar = xcd_barrier_post((unsigned*)(ws + WS_BAR), xst);
#ifndef PH_MASK
#define PH_MASK 0x1fff
#endif
#define IN(k) (((PH_MASK >> (k)) & 1) && lo <= (k) && (k) < hi)
#define SEAM(k) do { if (IN(k) && IN((k) + 1)) { if ((k) == 0) grid.sync(); else xcd_barrier(xbar); } } while (0)
    if (IN(0)) { p0_prologue(a, lds); } SEAM(0);
    if (IN(1)) {
        pg8::Gemm g{(const bf16_t*)((const unsigned char*)a.out + OUT_XB), (const bf16_t*)(ws + WS_BT_IN), M_TOK, NPROJ, DM, DM, DM}; pg8::StaticOrder S; S.init(M_TOK, NPROJ, G, bx);
        pg8::EpiProj E{(bf16_t*)(ws + WS_R2), (bf16_t*)(ws + WS_R1), (const float*)(ws + WS_RSTD1)};
        pg8::gemm_phase<pg8::EpiProj, pg8::StaticOrder, true, true>(lds, g, S, E);
    } SEAM(1);
    if (IN(2)) { p2_lora_in(a); p2_na(a, lds); } SEAM(2);
    {
        const bf16_t* li = (const bf16_t*)(ws + WS_R3) + 1024;
        if (IN(3)) { pg8::Gemm g{li, (const bf16_t*)(ws + WS_BT_W), M_TOK, 2048, 128, DM, 128}; pg8::StaticOrder S; S.init(M_TOK, 2048, G, bx);
          pg8::EpiLora<0> E{(bf16_t*)(ws + WS_OMD), 2048, a.in[8]}; pg8::gemm_phase<pg8::EpiLora<0>, pg8::StaticOrder, true, true>(lds, g, S, E); }
        if (IN(4)) { pg8::Gemm g{li + 128, (const bf16_t*)(ws + WS_BT_A), M_TOK, 2048, 128, DM, 128}; pg8::StaticOrder S; S.init(M_TOK, 2048, G, bx);
          pg8::EpiLora<1> E{(bf16_t*)((unsigned char*)a.out + OUT_A), 2048, a.in[10]}; pg8::gemm_phase<pg8::EpiLora<1>, pg8::StaticOrder, true, true>(lds, g, S, E); }
        if (IN(5)) { pg8::Gemm g{li + 256, (const bf16_t*)(ws + WS_BT_G), M_TOK, 1024, 256, DM, 256}; pg8::StaticOrder S; S.init(M_TOK, 1024, G, bx);
          pg8::EpiLora<2> E{(bf16_t*)(ws + WS_G), 1024, nullptr}; pg8::gemm_phase<pg8::EpiLora<2>, pg8::StaticOrder, true, true>(lds, g, S, E); }
    } SEAM(5);
    if (IN(6)) { p4_scan(a, lds); } SEAM(6);
    if (IN(7)) { p6_corr(a, lds); } SEAM(7);
    if (IN(8)) { p5_post(a); } SEAM(8);
    if (IN(9)) {
        pg8::Gemm g{(const bf16_t*)(ws + WS_R3), (const bf16_t*)(ws + WS_BT_OUT), M_TOK, DM, DM, DM, DM}; pg8::StaticOrder S; S.init(M_TOK, DM, G, bx);
        pg8::EpiOut E{a.in[0], a.in[1], (bf16_t*)(ws + WS_X1B), (float*)(ws + WS_SS2)};
        pg8::gemm_phase<pg8::EpiOut, pg8::StaticOrder, true, true>(lds, g, S, E);
    } SEAM(9);
    if (IN(10)) {
        pg8::Gemm g{(const bf16_t*)(ws + WS_X1B), (const bf16_t*)(ws + WS_BT_GU), M_TOK, FF2, DM, DM, DM}; pg8::StaticOrder S; S.init(M_TOK, FF2, G, bx);
        pg8::EpiGU E{(bf16_t*)(ws + WS_H), (const float*)(ws + WS_SS2)};
        pg8::gemm_phase<pg8::EpiGU, pg8::StaticOrder, true, true>(lds, g, S, E);
    } SEAM(10);
    if (IN(11)) {
        pg8::Gemm g{(const bf16_t*)(ws + WS_H), (const bf16_t*)(ws + WS_BT_DOWN), M_TOK, DM, FF, FF, FF}; pg8::StaticOrder S; S.init(M_TOK, DM, G, bx);
        pg8::EpiDown E{(bf16_t*)(ws + WS_X1B), (float*)(ws + WS_SS3)};
        pg8::gemm_phase<pg8::EpiDown, pg8::StaticOrder, true, true>(lds, g, S, E);
    } SEAM(11);
    if (IN(12)) { p9_final(a); }
}

#ifndef MK_LAUNCHES
#define MK_LAUNCHES 1
#endif
extern "C" void kernel_launch(void* const* d_in, const int* in_sizes, int n_in, void* d_out, int out_size, void* d_ws, size_t ws_size, hipStream_t stream) {
    static int grid = 0;
    if (grid == 0) {
        if (n_in != 24 || out_size != M_TOK * DM || ws_size < WS_END) { fprintf(stderr, "kernel_launch: unexpected shapes: n_in %d out %d ws %zu (need %zu)\n", n_in, out_size, ws_size, (size_t)WS_END); grid = -1; return; }
        if (hipFuncSetAttribute((const void*)fwd_mega, hipFuncAttributeMaxDynamicSharedMemorySize, LDS_BYTES) != hipSuccess) { fprintf(stderr, "kernel_launch: hipFuncSetAttribute failed\n"); grid = -1; return; }
        int dev = 0, cus = 0, per_cu = 0;
        hipGetDevice(&dev); hipDeviceGetAttribute(&cus, hipDeviceAttributeMultiprocessorCount, dev);
        hipOccupancyMaxActiveBlocksPerMultiprocessor(&per_cu, (const void*)fwd_mega, 512, LDS_BYTES);
        (void)hipGetLastError();
        if (per_cu < 1) per_cu = 1;
        grid = cus;
        if (grid % 8 != 0) grid = (grid / 8) * 8;
    }
    if (grid < 0) return;
    Args a{};
    for (int i = 0; i < 24; ++i) a.in[i] = (const float*)d_in[i];
    a.out = (float*)d_out; a.ws = (unsigned char*)d_ws;
    if (MK_LAUNCHES == 1) {
        (void)hipMemsetAsync((unsigned char*)d_ws + WS_BAR, 0, 16384, stream);
        a.ph_lo = 0; a.ph_hi = NPH; void* args[] = {&a};
        hipError_t e = hipLaunchCooperativeKernel((const void*)fwd_mega, dim3(grid), dim3(512), args, LDS_BYTES, stream);
        if (e != hipSuccess) fprintf(stderr, "cooperative launch failed: %s (grid %d)\n", hipGetErrorString(e), grid);
    } else {
        for (int ph = 0; ph < NPH; ++ph) { a.ph_lo = ph; a.ph_hi = ph + 1; void* args[] = {&a};
            hipError_t e = hipLaunchCooperativeKernel((const void*)fwd_mega, dim3(grid), dim3(512), args, LDS_BYTES, stream);
            if (e != hipSuccess) { fprintf(stderr, "launch %d failed: %s (grid %d)\n", ph, hipGetErrorString(e), grid); break; } }
    }
}
```
